# Optimizing an MI355X kernel written in HIP

```python
import jax
import jax.numpy as jnp
from jax import lax
import numpy as np

D_MODEL = 4096
BATCH = 4
SEQ = 2048
DEPTH = 4

GRID_W = 64
CTX_LEN = 256
FOURIER_GROUPS = 4
FOURIER_GROUP_W = D_MODEL // 16
FOURIER_W = FOURIER_GROUPS * FOURIER_GROUP_W
CONV_W = D_MODEL // 4
CONV_K = 31
MLA_HEADS = D_MODEL // 256
Q_LORA = D_MODEL // 4
KV_LORA = D_MODEL // 8
QK_NOPE = 128
QK_ROPE = 64
V_DIM = 128
MLA_W = MLA_HEADS * V_DIM
ROPE_THETA = 10000.0
ROPE_FREQS = QK_ROPE // 4
ATTN_SCALE = (QK_NOPE + QK_ROPE) ** -0.5
Q_BLOCK = 128
N_BRANCH = 3
GATE_RANK = 512
MOD_RANK = 256
N_MOD = 6
D_FF = 4 * D_MODEL
EPS = 1e-6
OFF_C = FOURIER_W
OFF_Q = OFF_C + 2 * CONV_W
OFF_KV = OFF_Q + Q_LORA
D_IN = OFF_KV + KV_LORA + QK_ROPE

kernel_name = "hybrid_fourier_conformer_mla_dit"


def rms_norm(x, g):
    x32 = x.astype(jnp.float32)
    y = x32 * lax.rsqrt(jnp.mean(jnp.square(x32), axis=-1, keepdims=True) + EPS)
    return (y * g.astype(jnp.float32)).astype(x.dtype)


def layer_norm(x, g, b):
    x32 = x.astype(jnp.float32)
    xc = x32 - jnp.mean(x32, axis=-1, keepdims=True)
    y = xc * lax.rsqrt(jnp.mean(jnp.square(xc), axis=-1, keepdims=True) + EPS)
    return (y * g.astype(jnp.float32) + b.astype(jnp.float32)).astype(x.dtype)


def axial_rope_tables(n_tokens):
    n_rows = n_tokens // GRID_W
    rows = jnp.repeat(jnp.arange(n_rows, dtype=jnp.float32), GRID_W)
    cols = jnp.tile(jnp.arange(GRID_W, dtype=jnp.float32), n_rows)
    pos = jnp.stack([rows, cols], axis=-1)
    inv_freq = jnp.power(ROPE_THETA, -jnp.arange(ROPE_FREQS, dtype=jnp.float32) / ROPE_FREQS)
    ang = pos[:, :, None] * inv_freq
    return jnp.cos(ang), jnp.sin(ang)


def apply_rope(x, cos, sin):
    xs = x.reshape(x.shape[:-1] + (2, 2, ROPE_FREQS))
    x1, x2 = xs[..., 0, :], xs[..., 1, :]
    cos = cos.astype(x.dtype)
    sin = sin.astype(x.dtype)
    out = jnp.stack([x1 * cos - x2 * sin, x2 * cos + x1 * sin], axis=-2)
    return out.reshape(x.shape)


def adaln(cond, w_a, w_b, b):
    m = (jax.nn.silu(cond) @ w_a) @ w_b + b
    return jnp.split(m, N_MOD, axis=-1)


def modulate(x, g, shift, scale):
    return rms_norm(x, g) * (1 + scale) + shift


def fourier_mix(u):
    b, l, _ = u.shape
    ug = u.astype(jnp.float32).reshape(b, l, FOURIER_GROUPS, FOURIER_GROUP_W)
    f = jnp.fft.fft2(ug, axes=(1, 3), norm="ortho").real
    return f.reshape(b, l, FOURIER_W).astype(u.dtype)


def conformer_conv(u, conv_w, conv_b, ln_g, ln_b):
    a, gt = jnp.split(u, 2, axis=-1)
    v = a * jax.nn.sigmoid(gt)
    y = lax.conv_general_dilated(
        v, conv_w[:, None, :].astype(v.dtype), window_strides=(1,),
        padding=((CONV_K // 2, CONV_K // 2),), dimension_numbers=("NWC", "WIO", "NWC"),
        feature_group_count=CONV_W)
    return jax.nn.silu(layer_norm(y + conv_b, ln_g, ln_b))


def mla_queries(cq, q_norm_g, w_uq, rope):
    b, l, _ = cq.shape
    q = (rms_norm(cq, q_norm_g) @ w_uq).reshape(b, l, MLA_HEADS, QK_NOPE + QK_ROPE)
    qn, qr = q[..., :QK_NOPE], q[..., QK_NOPE:]
    if rope is not None:
        qr = apply_rope(qr, rope[0][:, None], rope[1][:, None])
    return qn, qr


def mla_keys(ckv, kv_norm_g, w_ukv, rope):
    b, l, _ = ckv.shape
    c_kv, kr = ckv[..., :KV_LORA], ckv[..., KV_LORA:]
    kv = (rms_norm(c_kv, kv_norm_g) @ w_ukv).reshape(b, l, MLA_HEADS, QK_NOPE + V_DIM)
    kn, v = kv[..., :QK_NOPE], kv[..., QK_NOPE:]
    if rope is not None:
        kr = apply_rope(kr, rope[0], rope[1])
    return kn, kr, v


def mla_attend(qn, qr, kn, kr, v):
    s = (jnp.einsum("bqhd,bkhd->bhqk", qn, kn, preferred_element_type=jnp.float32)
         + jnp.einsum("bqhr,bkr->bhqk", qr, kr, preferred_element_type=jnp.float32))
    p = jax.nn.softmax(s * ATTN_SCALE, axis=-1).astype(v.dtype)
    return jnp.einsum("bhqk,bkhd->bqhd", p, v)


def mla_attend_blocked(qn, qr, kn, kr, v):
    b, l, h, _ = qn.shape
    nb = l // Q_BLOCK

    def to_blocks(t):
        return jnp.moveaxis(t.reshape((b, nb, Q_BLOCK) + t.shape[2:]), 1, 0)

    o = lax.map(lambda q: mla_attend(q[0], q[1], kn, kr, v), (to_blocks(qn), to_blocks(qr)))
    return jnp.moveaxis(o, 0, 1).reshape(b, l, h, V_DIM)


def token_mixer(h, u, own_kv, ctx_kv, rope, lp):
    b, l, _ = h.shape
    y_f = fourier_mix(u[..., :OFF_C]) @ lp["w_pf"]
    y_c = conformer_conv(u[..., OFF_C:OFF_Q], lp["conv_w"], lp["conv_b"],
                         lp["conv_ln_g"], lp["conv_ln_b"]) @ lp["w_pc"]
    qn, qr = mla_queries(u[..., OFF_Q:OFF_KV], lp["q_norm_g"], lp["w_uq"], rope)
    kn, kr, v = own_kv
    if ctx_kv is None:
        o = mla_attend(qn, qr, kn, kr, v)
    else:
        kn = jnp.concatenate([kn, ctx_kv[0]], axis=1)
        kr = jnp.concatenate([kr, ctx_kv[1]], axis=1)
        v = jnp.concatenate([v, ctx_kv[2]], axis=1)
        o = mla_attend_blocked(qn, qr, kn, kr, v)
    y_m = o.reshape(b, l, MLA_W) @ lp["w_pm"]
    gates = jax.nn.sigmoid((h @ lp["w_gate_a"]) @ lp["w_gate_b"] + lp["b_gate"])
    g_f, g_c, g_m = jnp.split(gates, N_BRANCH, axis=-1)
    return (g_f * y_f + g_c * y_c + g_m * y_m) @ lp["w_out"]


def sq_relu_mlp(h, w1, w2):
    return jnp.square(jax.nn.relu(h @ w1)) @ w2


def setup_inputs(seed: int = 0) -> dict:
    key = jax.random.key(seed)
    ks = list(jax.random.split(key, 32))

    def nrm(k, shape, scale):
        return jax.random.normal(k, shape, jnp.float32) * scale

    def gain(k, shape):
        return 1.0 + 0.05 * jax.random.normal(k, shape, jnp.float32)

    L = DEPTH
    return {
        "x": nrm(ks[0], (BATCH, SEQ, D_MODEL), 1.0),
        "c": nrm(ks[1], (BATCH, D_MODEL), 1.0),
        "ctx": nrm(ks[2], (BATCH, CTX_LEN, D_MODEL), 1.0),
        "c_ctx": nrm(ks[3], (D_MODEL,), 1.0),
        "g_mix_pre": gain(ks[4], (L, D_MODEL)),
        "g_mix_post": gain(ks[5], (L, D_MODEL)),
        "g_mlp_pre": gain(ks[6], (L, D_MODEL)),
        "g_mlp_post": gain(ks[7], (L, D_MODEL)),
        "w_mod_a": nrm(ks[8], (L, D_MODEL, MOD_RANK), D_MODEL ** -0.5),
        "w_mod_b": nrm(ks[9], (L, MOD_RANK, N_MOD * D_MODEL), 0.5 * MOD_RANK ** -0.5),
        "b_mod": nrm(ks[10], (L, N_MOD * D_MODEL), 0.02),
        "w_in": nrm(ks[11], (L, D_MODEL, D_IN), D_MODEL ** -0.5),
        "conv_w": nrm(ks[12], (L, CONV_K, CONV_W), CONV_K ** -0.5),
        "conv_b": nrm(ks[13], (L, CONV_W), 0.02),
        "conv_ln_g": gain(ks[14], (L, CONV_W)),
        "conv_ln_b": nrm(ks[15], (L, CONV_W), 0.02),
        "q_norm_g": gain(ks[16], (L, Q_LORA)),
        "w_uq": nrm(ks[17], (L, Q_LORA, MLA_HEADS * (QK_NOPE + QK_ROPE)), Q_LORA ** -0.5),
        "kv_norm_g": gain(ks[18], (L, KV_LORA)),
        "w_ukv": nrm(ks[19], (L, KV_LORA, MLA_HEADS * (QK_NOPE + V_DIM)), KV_LORA ** -0.5),
        "w_pf": nrm(ks[20], (L, FOURIER_W, D_MODEL), FOURIER_W ** -0.5),
        "w_pc": nrm(ks[21], (L, CONV_W, D_MODEL), CONV_W ** -0.5),
        "w_pm": nrm(ks[22], (L, MLA_W, D_MODEL), MLA_W ** -0.5),
        "w_gate_a": nrm(ks[23], (L, D_MODEL, GATE_RANK), D_MODEL ** -0.5),
        "w_gate_b": nrm(ks[24], (L, GATE_RANK, N_BRANCH * D_MODEL), GATE_RANK ** -0.5),
        "b_gate": nrm(ks[25], (L, N_BRANCH * D_MODEL), 0.02),
        "w_out": nrm(ks[26], (L, D_MODEL, D_MODEL), D_MODEL ** -0.5),
        "w_ff1": nrm(ks[27], (L, D_MODEL, D_FF), D_MODEL ** -0.5),
        "w_ff2": nrm(ks[28], (L, D_FF, D_MODEL), D_FF ** -0.5),
    }


def reference(x, c, ctx, c_ctx, g_mix_pre, g_mix_post, g_mlp_pre, g_mlp_post,
              w_mod_a, w_mod_b, b_mod, w_in, conv_w, conv_b, conv_ln_g, conv_ln_b,
              q_norm_g, w_uq, kv_norm_g, w_ukv, w_pf, w_pc, w_pm,
              w_gate_a, w_gate_b, b_gate, w_out, w_ff1, w_ff2):
    rope = axial_rope_tables(x.shape[1])
    t = ctx
    for i in range(DEPTH):
        last = i == DEPTH - 1
        lp = {
            "conv_w": conv_w[i], "conv_b": conv_b[i], "conv_ln_g": conv_ln_g[i],
            "conv_ln_b": conv_ln_b[i], "q_norm_g": q_norm_g[i], "w_uq": w_uq[i],
            "w_pf": w_pf[i], "w_pc": w_pc[i], "w_pm": w_pm[i],
            "w_gate_a": w_gate_a[i], "w_gate_b": w_gate_b[i], "b_gate": b_gate[i],
            "w_out": w_out[i],
        }
        sx_a, cx_a, gx_a, sx_m, cx_m, gx_m = adaln(c[:, None, :], w_mod_a[i], w_mod_b[i], b_mod[i])
        st_a, ct_a, gt_a, st_m, ct_m, gt_m = adaln(c_ctx[None, None, :], w_mod_a[i], w_mod_b[i], b_mod[i])

        ht = modulate(t, g_mix_pre[i], st_a, ct_a)
        ut = ht @ w_in[i]
        kv_t = mla_keys(ut[..., OFF_KV:], kv_norm_g[i], w_ukv[i], None)
        hx = modulate(x, g_mix_pre[i], sx_a, cx_a)
        ux = hx @ w_in[i]
        kv_x = mla_keys(ux[..., OFF_KV:], kv_norm_g[i], w_ukv[i], rope)
        yx = token_mixer(hx, ux, kv_x, kv_t, rope, lp)
        x = x + gx_a * rms_norm(yx, g_mix_post[i])

        hx = modulate(x, g_mlp_pre[i], sx_m, cx_m)
        x = x + gx_m * rms_norm(sq_relu_mlp(hx, w_ff1[i], w_ff2[i]), g_mlp_post[i])

        if not last:
            yt = token_mixer(ht, ut, kv_t, None, None, lp)
            t = t + gt_a * rms_norm(yt, g_mix_post[i])
            ht = modulate(t, g_mlp_pre[i], st_m, ct_m)
            t = t + gt_m * rms_norm(sq_relu_mlp(ht, w_ff1[i], w_ff2[i]), g_mlp_post[i])
    return x
```

```cpp
#include <hip/hip_runtime.h>
#include <cstdio>

#ifndef ONE_LAUNCH
#define ONE_LAUNCH 1
#endif

#define LAS __attribute__((address_space(3)))
#define GAS __attribute__((address_space(1)))
typedef unsigned short bf16_t;
typedef short bf16x8 __attribute__((ext_vector_type(8)));
typedef float f32x4 __attribute__((ext_vector_type(4)));
typedef float f32x2 __attribute__((ext_vector_type(2)));
typedef unsigned u32x4 __attribute__((ext_vector_type(4)));
typedef unsigned u32x2 __attribute__((ext_vector_type(2)));

constexpr int DM = 4096, NB = 4, SEQ = 2048, CTXL = 256, DEPTH = 4;
constexpr int NX = NB * SEQ, NT = NB * CTXL, NR = NX + NT;
constexpr int NU = 5376;
constexpr int U_F = 0, U_CA = 1024, U_CG = 2048, U_Q = 3072, U_KV = 4096, U_KR = 4608, U_GA = 4672, U_END = 5184;
constexpr int DIN = 4672, DFF = 16384;
constexpr float EPS = 1e-6f;
constexpr float ATTN_SCALE = 0.07216878364870322f;
constexpr float QSCALE = 0.07216878364870322f * 1.4426950408889634f;

constexpr size_t MiB = 1ull << 20;
constexpr size_t WS_CTL = 0, CTL_BYTES = 32768;
constexpr size_t WS_W = 1 * MiB, LW = 384 * MiB;
constexpr size_t OW_IN = 0, OW_UQ = OW_IN + 5376ull * 4096 * 2, OW_UKV = OW_UQ + 3072ull * 1024 * 2, OW_PF = OW_UKV + 4096ull * 512 * 2,
                 OW_PC = OW_PF + 4096ull * 1024 * 2, OW_PM = OW_PC + 4096ull * 1024 * 2, OW_GB = OW_PM + 4096ull * 2048 * 2,
                 OW_OUT = OW_GB + 12288ull * 512 * 2, OW_1 = OW_OUT + 4096ull * 4096 * 2, OW_2 = OW_1 + 16384ull * 4096 * 2;
static_assert(OW_2 + 4096ull * 16384 * 2 == LW, "per-layer weight map");
constexpr size_t WS_DFTX = WS_W + 4 * LW;
constexpr size_t WS_DFTT = WS_DFTX + 16 * MiB;
constexpr size_t WS_DFTC = WS_DFTT + 1 * MiB;
constexpr size_t WS_ROPE = WS_DFTC + 1 * MiB;
constexpr size_t WS_A1 = WS_ROPE + 1 * MiB;
constexpr size_t WS_MODS = WS_A1 + 1 * MiB;
constexpr size_t WS_RES = WS_MODS + 2 * MiB;
constexpr size_t WS_H = WS_RES + 144 * MiB;
constexpr size_t WS_U = WS_H + 72 * MiB;
constexpr size_t WS_UFTX = WS_U + 95 * MiB;
constexpr size_t WS_UFTT = WS_UFTX + 16 * MiB;
constexpr size_t WS_G = WS_UFTT + 2 * MiB;
constexpr size_t WS_F = WS_G + 36 * MiB;
constexpr size_t WS_CACT = WS_F + 18 * MiB;
constexpr size_t WS_QIN = WS_CACT + 18 * MiB;
constexpr size_t WS_KVIN = WS_QIN + 18 * MiB;
constexpr size_t WS_KR = WS_KVIN + 9 * MiB;
constexpr size_t WS_Q = WS_KR + 2 * MiB;
constexpr size_t WS_KN = WS_Q + 54 * MiB;
constexpr size_t WS_VT = WS_KN + 36 * MiB;
constexpr size_t WS_O = WS_VT + 36 * MiB;
constexpr size_t WS_GATES = WS_O + 36 * MiB;
constexpr size_t WS_M1 = WS_GATES + 216 * MiB;
constexpr size_t WS_MERGED = WS_M1 + 144 * MiB;
constexpr size_t WS_Y = WS_MERGED + 72 * MiB;
constexpr size_t WS_HID = WS_Y + 144 * MiB;
constexpr size_t WS_YS = WS_HID + 288 * MiB;
constexpr size_t WS_END = WS_YS + 64 * MiB;

constexpr int CW_BAR = 4096;
static_assert((CW_BAR + 3456) * 4 <= (int)CTL_BYTES, "barrier words inside the per-call memset");

constexpr int RING_BYTES = 133120;
constexpr int MISC_OFF = RING_BYTES + 256;
constexpr int LDS_BYTES = 147456;

__device__ __forceinline__ float bf2f(unsigned b) { return __uint_as_float(b << 16); }
__device__ __forceinline__ float bflo(unsigned w) { return __uint_as_float(w << 16); }
__device__ __forceinline__ float bfhi(unsigned w) { return __uint_as_float(w & 0xffff0000u); }
__device__ __forceinline__ unsigned f2bf(float f) { unsigned u = __float_as_uint(f); return (u + 0x7fffu + ((u >> 16) & 1u)) >> 16; }
__device__ __forceinline__ unsigned pk2(float lo, float hi) { return f2bf(lo) | (f2bf(hi) << 16); }
typedef __bf16 bf16x2_t __attribute__((ext_vector_type(2)));
__device__ __forceinline__ unsigned pkbf(float lo, float hi) { const f32x2 v = {lo, hi}; return __builtin_bit_cast(unsigned, __builtin_convertvector(v, bf16x2_t)); }
__device__ __forceinline__ float sigmoidf_(float x) { return __builtin_amdgcn_rcpf(1.0f + __builtin_amdgcn_exp2f(-1.4426950408889634f * x)); }
__device__ __forceinline__ float wave_sum(float v) {
#pragma unroll
    for (int o = 1; o < 64; o <<= 1) v += __shfl_xor(v, o);
    return v;
}
__device__ __forceinline__ float wave_max(float v) {
#pragma unroll
    for (int o = 1; o < 64; o <<= 1) v = fmaxf(v, __shfl_xor(v, o));
    return v;
}
#define LDS_WAIT() asm volatile("s_waitcnt lgkmcnt(0)" ::: "memory")
__device__ __forceinline__ int fresh_tid() { int t = threadIdx.x; asm volatile("" : "+v"(t)); return t; }

#define XB_TMO      128
#define XB_XCNT(j)  (256  + 64 * (j))
#define XB_XSUB(j)  (1280 + 64 * (j))
#define XB_XGEN(j)  (2304 + 64 * (j))
#define XB_TOP      3328
#define XB_TOPGEN   3392
#define XCD_BAR_WORDS 3456
#define XB_SPIN_CAP (1u << 18)

__device__ __forceinline__ unsigned xb_ld(unsigned* p)              { return __hip_atomic_load(p, __ATOMIC_RELAXED, __HIP_MEMORY_SCOPE_AGENT); }
__device__ __forceinline__ unsigned xb_add(unsigned* p, unsigned v) { return __hip_atomic_fetch_add(p, v, __ATOMIC_RELAXED, __HIP_MEMORY_SCOPE_AGENT); }
__device__ __forceinline__ unsigned xb_xcc_id() { return (unsigned)__builtin_amdgcn_s_getreg((3 << 11) | 20) & 0xFu; }
#define XB_SPIN(cond, bar) do { unsigned _sp = 0; while (cond) { __builtin_amdgcn_s_sleep(1); \
    if ((++_sp & 255u) == 0u) { if (xb_ld(&(bar)[XB_TMO])) break; if (_sp > XB_SPIN_CAP) { atomicAdd(&(bar)[XB_TMO], 1u); break; } } } } while (0)

struct XcdBarrier { unsigned* bar; unsigned x; volatile LAS unsigned* st; };

__device__ __forceinline__ XcdBarrier xcd_barrier_post(unsigned* bar, volatile LAS unsigned* st) {
    XcdBarrier b; b.bar = bar; b.x = xb_xcc_id(); b.st = st;
    if (threadIdx.x == 0) (void)xb_add(&bar[XB_XCNT(b.x)], 1u);
    return b;
}
__device__ __forceinline__ void xcd_barrier_complete(unsigned* bar, unsigned x, unsigned& nloc, unsigned& nx) {
    const unsigned G = gridDim.x * gridDim.y * gridDim.z;
    unsigned sum, cnt, mine, sp = 0u;
    for (;;) {
        sum = 0u; cnt = 0u; mine = 0u;
#pragma unroll
        for (unsigned j = 0; j < 16; ++j) { const unsigned c = xb_ld(&bar[XB_XCNT(j)]); sum += c; cnt += (c > 0u) ? 1u : 0u; mine = (j == x) ? c : mine; }
        if (sum == G) break;
        __builtin_amdgcn_s_sleep(1);
        if ((++sp & 255u) == 0u) { if (xb_ld(&bar[XB_TMO])) break; if (sp > XB_SPIN_CAP) { atomicAdd(&bar[XB_TMO], 1u); break; } }
    }
    nloc = mine > 0u ? mine : 1u; nx = cnt > 0u ? cnt : 1u;
}
__device__ __forceinline__ void xcd_barrier(const XcdBarrier& b) {
    asm volatile("s_waitcnt vmcnt(0)" ::: "memory");
    __syncthreads();
    if (threadIdx.x == 0) {
        unsigned* bar = b.bar;
        __builtin_amdgcn_s_waitcnt(0);
        unsigned nloc = b.st[0], nx = b.st[1];
        if (nloc == 0u) { xcd_barrier_complete(bar, b.x, nloc, nx); b.st[0] = nloc; b.st[1] = nx; }
        const unsigned old = xb_add(&bar[XB_XSUB(b.x)], 1u);
        const unsigned gen = old / nloc;
        if (old + 1u == (gen + 1u) * nloc) {
            __builtin_amdgcn_fence(__ATOMIC_RELEASE, "agent");
            asm volatile("s_waitcnt vmcnt(0)" ::: "memory");
            const unsigned og = xb_add(&bar[XB_TOP], 1u);
            const unsigned tg = og / nx;
            if (og + 1u == (tg + 1u) * nx) xb_add(&bar[XB_TOPGEN], 1u);
            else XB_SPIN(xb_ld(&bar[XB_TOPGEN]) == tg, bar);
            __builtin_amdgcn_fence(__ATOMIC_ACQUIRE, "agent");
            xb_add(&bar[XB_XGEN(b.x)], 1u);
            asm volatile("s_waitcnt vmcnt(0)" ::: "memory");
        } else {
            XB_SPIN(xb_ld(&bar[XB_XGEN(b.x)]) == gen, bar);
            __builtin_amdgcn_fence(__ATOMIC_ACQUIRE, "agent");
            asm volatile("s_waitcnt vmcnt(0)" ::: "memory");
        }
    }
    __syncthreads();
}

namespace pg8 {
constexpr int BM = 256, BK = 64, HALF = 128, HTB = HALF * BK * 2, STAGE_BYTES = 8 * HTB, NXCD = 8, WGM = 4;
__host__ __device__ __forceinline__ int lds_byte(int r, int c) { const int st = (r >> 4) * 2 + (c >> 5), rr = r & 15, cc = c & 31, ob = rr * 64 + cc * 2; return st * 1024 + (ob ^ (((ob >> 9) & 1) << 5)); }
__host__ __device__ __forceinline__ void stage_rc(int b, int& R, int& C) { const int st = b / 1024, sb = b % 1024, swz = sb ^ (((sb >> 9) & 1) << 5); R = (st >> 1) * 16 + swz / 64; C = (st & 1) * 32 + (swz % 64) / 2; }
__host__ __device__ __forceinline__ int perm32(int rho) { const int n = rho >> 4, i = rho & 15; return 8 * (i >> 2) + 4 * n + (i & 3); }

struct Unit { int pm, pn, z; };
struct Gemm { const bf16_t* A; const bf16_t* Bt; int lda, ldb, K; size_t aZ, bZ; };

struct Order {
    int nM, nN, nwg, nZ, G, c, Lend;
    __device__ __forceinline__ void init(int nM_, int nN_, int nZ_, int G_, int c_) { nM = nM_; nN = nN_; nwg = nM * nN; nZ = nZ_; G = G_; c = c_; Lend = nwg * nZ; }
    __device__ __forceinline__ bool next(int i, Unit& u) const {
        const int L = i * G + c; if (L >= Lend) return false;
        const int zz = (L >= nwg ? 1 : 0) + (L >= 2 * nwg ? 1 : 0) + (L >= 3 * nwg ? 1 : 0);
        u.z = zz; int wgid = L - zz * nwg;
        { const int q = nwg / NXCD, r = nwg % NXCD, xcd = wgid % NXCD, off = wgid / NXCD; wgid = (xcd < r ? xcd * (q + 1) : r * (q + 1) + (xcd - r) * q) + off; }
        const int nig = WGM * nN, gid = wgid / nig, fm = gid * WGM, gsz = (nM - fm) < WGM ? (nM - fm) : WGM;
        u.pm = fm + ((wgid % nig) % gsz); u.pn = (wgid % nig) / gsz; return true;
    }
};

template <bool ALIGN_EPI = true, bool SP2 = true, class Epi, class Sched>
__device__ __forceinline__ void gemm_phase(LAS unsigned char* lds, const Gemm g, const Sched& S, const Epi& E) {
    const int tid = fresh_tid(), wid = __builtin_amdgcn_readfirstlane(tid >> 6), lane = tid & 63, wr = wid >> 2, wc = wid & 3, fr = lane & 15, fq = lane >> 4;
    const int K = g.K, nt = K / BK;
    unsigned voffA[2], voffB[2];
#pragma unroll
    for (int i = 0; i < 2; ++i) { int R, C; stage_rc(tid * 16 + i * 8192, R, C); const int Rb = Epi::PERM ? ((R & ~31) + perm32(R & 31)) : R;
        voffA[i] = (unsigned)(R * g.lda + C) * 2u; voffB[i] = (unsigned)(Rb * g.ldb + C) * 2u; }
    const size_t kstep = (size_t)(BK * 2);
    const size_t hA = (size_t)HALF * g.lda * 2, hB = (size_t)HALF * g.ldb * 2;
    const unsigned ldsw = (unsigned)wid * 1024u;
    const int aoff = lds_byte(wr * 64 + fr, fq * 8), boff = lds_byte(wc * 32 + fr, fq * 8);
#define PG8_SA(b, h) (((b) * 2 + (h)) * HTB)
#define PG8_SB(b, h) ((4 + (b) * 2 + (h)) * HTB)
#define PG8_STAGE(bufoff, gbase, voff) do { _Pragma("unroll") for (int _i = 0; _i < 2; ++_i) \
        __builtin_amdgcn_global_load_lds((const unsigned*)((const char*)(gbase) + (voff)[_i]), (LAS unsigned*)(lds + (bufoff) + ldsw + _i * 8192), 16, 0, 0); } while (0)
#define PG8_LDA(dst, b, h) do { _Pragma("unroll") for (int m = 0; m < 4; ++m) _Pragma("unroll") for (int k = 0; k < 2; ++k) dst[m][k] = *(const LAS bf16x8*)(lds + PG8_SA(b, h) + aoff + m * 2048 + k * 1024); } while (0)
#define PG8_LDB(dst, b, h) do { _Pragma("unroll") for (int n = 0; n < 2; ++n) _Pragma("unroll") for (int k = 0; k < 2; ++k) dst[n][k] = *(const LAS bf16x8*)(lds + PG8_SB(b, h) + boff + n * 2048 + k * 1024); } while (0)
#define PG8_MMA(ai, bj, At, Bt) do { __builtin_amdgcn_s_setprio(1); _Pragma("unroll") for (int m = 0; m < 4; ++m) _Pragma("unroll") for (int n = 0; n < 2; ++n) _Pragma("unroll") for (int k = 0; k < 2; ++k) \
        acc[ai][bj][m][n] = __builtin_amdgcn_mfma_f32_16x16x32_bf16(Bt[n][k], At[m][k], acc[ai][bj][m][n], 0, 0, 0); __builtin_amdgcn_s_setprio(0); } while (0)
#define PG8_WAIT_V(n) asm volatile("s_waitcnt vmcnt(" #n ")" ::: "memory")
#define PG8_WAIT_L(n) asm volatile("s_waitcnt lgkmcnt(" #n ")" ::: "memory")
#define PG8_BAR __builtin_amdgcn_s_barrier()
#define PG8_SCHED __builtin_amdgcn_sched_barrier(0)
#define PG8_ABASE(u) ((const char*)g.A + ((size_t)(u).z * g.aZ + (size_t)(u).pm * BM * g.lda) * 2)
#define PG8_BBASE(u) ((const char*)g.Bt + ((size_t)(u).z * g.bZ + (size_t)(u).pn * BM * g.ldb) * 2)
    Unit cur, nxt; int ui = 0;
    if (!S.next(0, cur)) return;
    f32x4 acc[2][2][4][2];
#pragma unroll
    for (int a = 0; a < 2; ++a)
#pragma unroll
        for (int b = 0; b < 2; ++b)
#pragma unroll
            for (int m = 0; m < 4; ++m)
#pragma unroll
                for (int n = 0; n < 2; ++n) acc[a][b][m][n] = (f32x4){0.f, 0.f, 0.f, 0.f};
    bf16x8 At[4][2], B0[2][2], B1[2][2];
    const char* cA = PG8_ABASE(cur); const char* cB = PG8_BBASE(cur);
    if constexpr (SP2) {
        PG8_STAGE(PG8_SB(0, 0), cB, voffB); PG8_STAGE(PG8_SB(0, 1), cB + hB, voffB); PG8_STAGE(PG8_SA(0, 0), cA, voffA); PG8_STAGE(PG8_SA(0, 1), cA + hA, voffA);
        if (wr == 1) PG8_BAR;
        PG8_WAIT_V(2); PG8_BAR;
        PG8_STAGE(PG8_SB(1, 0), cB + kstep, voffB); PG8_STAGE(PG8_SA(1, 0), cA + kstep, voffA); PG8_STAGE(PG8_SB(1, 1), cB + hB + kstep, voffB);
        PG8_WAIT_V(6); PG8_BAR;
    } else {
        PG8_STAGE(PG8_SB(0, 0), cB, voffB); PG8_STAGE(PG8_SA(0, 0), cA, voffA); PG8_STAGE(PG8_SB(0, 1), cB + hB, voffB); PG8_STAGE(PG8_SA(0, 1), cA + hA, voffA);
        if (wr == 1) PG8_BAR;
        PG8_WAIT_V(4); PG8_BAR;
        PG8_STAGE(PG8_SB(1, 0), cB + kstep, voffB); PG8_STAGE(PG8_SA(1, 0), cA + kstep, voffA); PG8_STAGE(PG8_SB(1, 1), cB + hB + kstep, voffB);
        PG8_WAIT_V(6); PG8_BAR;
    }
    for (;;) {
        const bool has_next = S.next(ui + 1, nxt);
        const char* nA = has_next ? PG8_ABASE(nxt) : cA; const char* nB = has_next ? PG8_BBASE(nxt) : cB;
        for (int t = 0; t < nt; t += 2) {
            const bool last = (t == nt - 2);
            const char* a1 = cA + (size_t)(t + 1) * kstep;
            const char* a2 = last ? nA : cA + (size_t)(t + 2) * kstep; const char* b2 = last ? nB : cB + (size_t)(t + 2) * kstep;
            const char* a3 = a2 + kstep; const char* b3 = b2 + kstep;
            if constexpr (SP2) {
            PG8_LDB(B0, 0, 0); PG8_LDB(B1, 0, 1); PG8_SCHED; PG8_LDA(At, 0, 0); PG8_STAGE(PG8_SA(1, 1), a1 + hA, voffA);
            PG8_WAIT_V(8); PG8_WAIT_L(0); PG8_BAR; PG8_MMA(0, 0, At, B0); PG8_MMA(0, 1, At, B1); PG8_BAR; PG8_SCHED;
            PG8_LDA(At, 0, 1); PG8_STAGE(PG8_SB(0, 0), b2, voffB); PG8_STAGE(PG8_SB(0, 1), b2 + hB, voffB); PG8_STAGE(PG8_SA(0, 0), a2, voffA);
            PG8_WAIT_V(8); PG8_WAIT_L(0); PG8_BAR; PG8_MMA(1, 0, At, B0); PG8_MMA(1, 1, At, B1); PG8_BAR; PG8_SCHED;
            PG8_LDB(B0, 1, 0); PG8_LDB(B1, 1, 1); PG8_SCHED; PG8_LDA(At, 1, 0); PG8_STAGE(PG8_SA(0, 1), a2 + hA, voffA);
            PG8_WAIT_V(8); PG8_WAIT_L(0); PG8_BAR; PG8_MMA(0, 0, At, B0); PG8_MMA(0, 1, At, B1); PG8_BAR; PG8_SCHED;
            PG8_LDA(At, 1, 1); PG8_STAGE(PG8_SB(1, 0), b3, voffB); PG8_STAGE(PG8_SB(1, 1), b3 + hB, voffB); PG8_STAGE(PG8_SA(1, 0), a3, voffA);
            PG8_WAIT_V(8); PG8_WAIT_L(0); PG8_BAR; PG8_MMA(1, 0, At, B0); PG8_MMA(1, 1, At, B1); PG8_BAR; PG8_SCHED;
            } else {
            PG8_LDB(B0, 0, 0); PG8_SCHED; PG8_LDA(At, 0, 0); PG8_STAGE(PG8_SA(1, 1), a1 + hA, voffA);
            PG8_WAIT_L(8); PG8_BAR; PG8_WAIT_L(0); PG8_MMA(0, 0, At, B0); PG8_BAR; PG8_SCHED;
            PG8_LDB(B1, 0, 1); PG8_STAGE(PG8_SB(0, 0), b2, voffB);
            PG8_BAR; PG8_WAIT_L(0); PG8_MMA(0, 1, At, B1); PG8_BAR;
            PG8_LDA(At, 0, 1); PG8_STAGE(PG8_SA(0, 0), a2, voffA);
            PG8_BAR; PG8_WAIT_L(0); PG8_MMA(1, 0, At, B0); PG8_BAR; PG8_SCHED;
            PG8_STAGE(PG8_SB(0, 1), b2 + hB, voffB);
            PG8_WAIT_V(6); PG8_BAR; PG8_MMA(1, 1, At, B1); PG8_BAR;
            PG8_LDB(B0, 1, 0); PG8_SCHED; PG8_LDA(At, 1, 0); PG8_STAGE(PG8_SA(0, 1), a2 + hA, voffA);
            PG8_WAIT_L(8); PG8_BAR; PG8_WAIT_L(0); PG8_MMA(0, 0, At, B0); PG8_BAR; PG8_SCHED;
            PG8_LDB(B1, 1, 1); PG8_STAGE(PG8_SB(1, 0), b3, voffB);
            PG8_BAR; PG8_WAIT_L(0); PG8_MMA(0, 1, At, B1); PG8_BAR;
            PG8_LDA(At, 1, 1); PG8_STAGE(PG8_SA(1, 0), a3, voffA);
            PG8_BAR; PG8_WAIT_L(0); PG8_MMA(1, 0, At, B0); PG8_BAR; PG8_SCHED;
            PG8_STAGE(PG8_SB(1, 1), b3 + hB, voffB);
            PG8_WAIT_V(6); PG8_BAR; PG8_MMA(1, 1, At, B1); PG8_BAR;
                    }
        }
        if constexpr (ALIGN_EPI) { if (wr == 0) PG8_BAR; }
        E(acc, cur, wr, wc, fr, fq);
        if (!has_next) break;
#pragma unroll
        for (int a = 0; a < 2; ++a)
#pragma unroll
            for (int b = 0; b < 2; ++b)
#pragma unroll
                for (int m = 0; m < 4; ++m)
#pragma unroll
                    for (int n = 0; n < 2; ++n) acc[a][b][m][n] = (f32x4){0.f, 0.f, 0.f, 0.f};
        cur = nxt; cA = nA; cB = nB; ++ui;
        if constexpr (ALIGN_EPI) { if (wr == 1) PG8_BAR; }
    }
    PG8_WAIT_V(0);
    if constexpr (!ALIGN_EPI) { if (wr == 0) PG8_BAR; }
    PG8_BAR;
#undef PG8_SA
#undef PG8_SB
#undef PG8_STAGE
#undef PG8_LDA
#undef PG8_LDB
#undef PG8_MMA
#undef PG8_WAIT_V
#undef PG8_WAIT_L
#undef PG8_BAR
#undef PG8_SCHED
#undef PG8_ABASE
#undef PG8_BBASE
}

typedef const f32x4 (&AccRef)[2][2][4][2];

struct EpiF32 {
    static constexpr bool PERM = false;
    float* C; int ldc; size_t zstride;
    __device__ __forceinline__ void operator()(AccRef acc, const Unit& u, int wr, int wc, int fr, int fq) const {
        const int row0 = u.pm * BM + wr * 64 + fr, col0 = u.pn * BM + wc * 32 + 4 * fq;
#pragma unroll
        for (int ai = 0; ai < 2; ++ai)
#pragma unroll
            for (int m = 0; m < 4; ++m) { float* rowp = C + (size_t)u.z * zstride + (size_t)(row0 + ai * HALF + m * 16) * ldc + col0;
#pragma unroll
                for (int bj = 0; bj < 2; ++bj)
#pragma unroll
                    for (int n = 0; n < 2; ++n) *(f32x4*)(rowp + bj * HALF + n * 16) = acc[ai][bj][m][n]; }
    }
};
template <int ACT> struct EpiBf16 {
    static constexpr bool PERM = true;
    bf16_t* O; int ldc; const float* bias; int zcol;
    __device__ __forceinline__ void operator()(AccRef acc, const Unit& u, int wr, int wc, int fr, int fq) const {
        const int row0 = u.pm * BM + wr * 64 + fr; const int ct = u.pn * BM + wc * 32 + 8 * fq; const int col0 = u.z * zcol + ct;
        f32x4 bv[2][2];
#pragma unroll
        for (int bj = 0; bj < 2; ++bj)
#pragma unroll
            for (int n = 0; n < 2; ++n) bv[bj][n] = bias ? *(const f32x4*)(bias + ct + bj * HALF + 4 * n) : (f32x4){0.f, 0.f, 0.f, 0.f};
#pragma unroll
        for (int ai = 0; ai < 2; ++ai)
#pragma unroll
            for (int m = 0; m < 4; ++m) { bf16_t* rowp = O + (size_t)(row0 + ai * HALF + m * 16) * ldc + col0;
#pragma unroll
                for (int bj = 0; bj < 2; ++bj) { f32x4 v0 = acc[ai][bj][m][0] + bv[bj][0], v1 = acc[ai][bj][m][1] + bv[bj][1];
                    if (ACT == 1) {
#pragma unroll
                        for (int j = 0; j < 4; ++j) { v0[j] = sigmoidf_(v0[j]); v1[j] = sigmoidf_(v1[j]); } }
                    if (ACT == 2) {
#pragma unroll
                        for (int j = 0; j < 4; ++j) { const float a = fmaxf(v0[j], 0.f), b = fmaxf(v1[j], 0.f); v0[j] = a * a; v1[j] = b * b; } }
                    u32x4 w; w.x = pkbf(v0[0], v0[1]); w.y = pkbf(v0[2], v0[3]); w.z = pkbf(v1[0], v1[1]); w.w = pkbf(v1[2], v1[3]);
                    *(u32x4*)(rowp + bj * HALF) = w; } }
    }
};
struct EpiUfT {
    static constexpr bool PERM = true;
    bf16_t* X; bf16_t* T;
    __device__ __forceinline__ void operator()(AccRef acc, const Unit& u, int wr, int wc, int fr, int fq) const {
        bf16_t* base; int ldc;
        if (u.pn < 32) { base = X + ((size_t)(u.pn >> 3) * 1024 + u.pm * 256) * 2048 + (u.pn & 7) * 256; ldc = 2048; }
        else { base = T + ((size_t)(u.pn - 32) * 1024 + u.pm * 256) * 256; ldc = 256; }
        const int rr = wr * 64 + fr, cc = wc * 32 + 8 * fq;
#pragma unroll
        for (int ai = 0; ai < 2; ++ai)
#pragma unroll
            for (int m = 0; m < 4; ++m) { bf16_t* rowp = base + (size_t)(rr + ai * HALF + m * 16) * ldc + cc;
#pragma unroll
                for (int bj = 0; bj < 2; ++bj) { const f32x4 v0 = acc[ai][bj][m][0], v1 = acc[ai][bj][m][1];
                    u32x4 w; w.x = pkbf(v0[0], v0[1]); w.y = pkbf(v0[2], v0[3]); w.z = pkbf(v1[0], v1[1]); w.w = pkbf(v1[2], v1[3]);
                    *(u32x4*)(rowp + bj * HALF) = w; } }
    }
};
struct EpiSeqDft {
    static constexpr bool PERM = true;
    bf16_t* G; int nk, L, row_base; unsigned mlim; int nyq;
    __device__ __forceinline__ void operator()(AccRef acc, const Unit& u, int wr, int wc, int fr, int fq) const {
        const int pq = u.pm >= nk ? 1 : 0, kt = u.pm - nk * pq;
        unsigned char* gb = (unsigned char*)(G + (size_t)(row_base + u.z * L) * 2048 + u.pn * 512 + pq * 256);
        const int rr = kt * 256 + wr * 64 + fr, cc = wc * 32 + 8 * fq;
        const unsigned o0 = (unsigned)(rr * 2048 + cc) * 2u, cm = (unsigned)L * 4096u + 4u * (unsigned)cc;
        const unsigned sgn = pq ? 0x80008000u : 0u;
#pragma unroll
        for (int ai = 0; ai < 2; ++ai)
#pragma unroll
            for (int m = 0; m < 4; ++m) { const unsigned o = o0 + (unsigned)((ai * HALF + m * 16) * 4096); const bool mir = (unsigned)(rr + ai * HALF + m * 16 - 1) < mlim;
#pragma unroll
                for (int bj = 0; bj < 2; ++bj) { const f32x4 v0 = acc[ai][bj][m][0], v1 = acc[ai][bj][m][1];
                    u32x4 w; w.x = pkbf(v0[0], v0[1]); w.y = pkbf(v0[2], v0[3]); w.z = pkbf(v1[0], v1[1]); w.w = pkbf(v1[2], v1[3]);
                    if (ai == 0 && m == 0) {
                        const bool sp = nyq && pq && rr == 0;
                        if (sp) { *(u32x4*)(gb + o + bj * HALF * 2 + (1024 * 4096 - 512)) = w; *(u32x4*)(gb + o + bj * HALF * 2 + 1024 * 4096) = (u32x4){0u, 0u, 0u, 0u}; w = (u32x4){0u, 0u, 0u, 0u}; }
                    }
                    *(u32x4*)(gb + o + bj * HALF * 2) = w;
                    if (mir) { u32x4 wm; wm.x = w.x ^ sgn; wm.y = w.y ^ sgn; wm.z = w.z ^ sgn; wm.w = w.w ^ sgn; *(u32x4*)(gb + (cm - o) + bj * HALF * 2) = wm; } } }
    }
};
struct EpiQRope {
    static constexpr bool PERM = false;
    bf16_t* Q; const float* rope;
    __device__ __forceinline__ void operator()(AccRef acc, const Unit& u, int wr, int wc, int fr, int fq) const {
        const int row0 = u.pm * BM + wr * 64 + fr, col0 = u.pn * BM + wc * 32 + 4 * fq;
        const bool xrows = (u.pm * BM) < NX;
#pragma unroll
        for (int bj = 0; bj < 2; ++bj) {
            const int grp = 8 * u.pn + 4 * bj + wc, gm = grp % 6; const bool is_rope = xrows && (gm >= 4); const int axis = gm - 4;
            f32x4 cs0[2][4], cs1[2][4];
            if (is_rope) {
#pragma unroll
                for (int ai = 0; ai < 2; ++ai)
#pragma unroll
                    for (int m = 0; m < 4; ++m) { const int n = (row0 + ai * HALF + m * 16) & (SEQ - 1); const int pos = axis ? (n & 63) : (n >> 6);
                        const float* rp = rope + (pos * 16 + 4 * fq) * 2; cs0[ai][m] = *(const f32x4*)rp; cs1[ai][m] = *(const f32x4*)(rp + 4); }
                asm volatile("" ::: "memory");
            }
#pragma unroll
            for (int ai = 0; ai < 2; ++ai)
#pragma unroll
                for (int m = 0; m < 4; ++m) {
                    const int row = row0 + ai * HALF + m * 16;
                    f32x4 x1 = acc[ai][bj][m][0] * QSCALE, x2 = acc[ai][bj][m][1] * QSCALE;
                    if (is_rope) {
                        const f32x4 c = (f32x4){cs0[ai][m][0], cs0[ai][m][2], cs1[ai][m][0], cs1[ai][m][2]}, sn = (f32x4){cs0[ai][m][1], cs0[ai][m][3], cs1[ai][m][1], cs1[ai][m][3]};
                        const f32x4 o1 = x1 * c - x2 * sn, o2 = x2 * c + x1 * sn; x1 = o1; x2 = o2;
                    }
                    bf16_t* p = Q + (size_t)row * 3072 + col0 + bj * HALF;
                    u32x2 w0, w1; w0.x = pkbf(x1[0], x1[1]); w0.y = pkbf(x1[2], x1[3]); w1.x = pkbf(x2[0], x2[1]); w1.y = pkbf(x2[2], x2[3]);
                    *(u32x2*)p = w0; *(u32x2*)(p + 16) = w1;
                }
        }
    }
};
__device__ __forceinline__ size_t gate_tile_off(int pm, int pncol  ) { return ((size_t)pm * 48 + pncol) * 65536; }
struct EpiGatesImg {
    static constexpr bool PERM = true;
    bf16_t* G; const float* bias;
    __device__ __forceinline__ void operator()(AccRef acc, const Unit& u, int wr, int wc, int fr, int fq) const {
        const int ct = u.pn * BM + wc * 32 + 8 * fq;
        const int wl = ((wr * 4 + wc) * 64 + fq * 16 + fr) * 8;
        bf16_t* tb = G + gate_tile_off(u.pm, u.pn) + wl;
        f32x4 bv[2][2];
#pragma unroll
        for (int bj = 0; bj < 2; ++bj)
#pragma unroll
            for (int n = 0; n < 2; ++n) bv[bj][n] = *(const f32x4*)(bias + ct + bj * HALF + 4 * n);
#pragma unroll
        for (int ai = 0; ai < 2; ++ai)
#pragma unroll
            for (int m = 0; m < 4; ++m)
#pragma unroll
                for (int bj = 0; bj < 2; ++bj) { f32x4 v0 = acc[ai][bj][m][0] + bv[bj][0], v1 = acc[ai][bj][m][1] + bv[bj][1];
#pragma unroll
                    for (int j = 0; j < 4; ++j) { v0[j] = sigmoidf_(v0[j]); v1[j] = sigmoidf_(v1[j]); }
                    u32x4 w; w.x = pkbf(v0[0], v0[1]); w.y = pkbf(v0[2], v0[3]); w.z = pkbf(v1[0], v1[1]); w.w = pkbf(v1[2], v1[3]);
                    *(u32x4*)(tb + (size_t)(((ai * 4 + m) * 2 + bj) * 4096)) = w; }
    }
};
template <int MODE> struct EpiGate {
    static constexpr bool PERM = true;
    bf16_t* MB; const bf16_t* gates; bf16_t* OUT;
    __device__ __forceinline__ void operator()(AccRef acc, const Unit& u, int wr, int wc, int fr, int fq) const {
        const int row0 = u.pm * BM + wr * 64 + fr, col0 = u.pn * BM + wc * 32 + 8 * fq;
        const int gtile = (MODE == 2) ? 32 : (u.z == 0 ? 16 : 0);
        const int wl = ((wr * 4 + wc) * 64 + fq * 16 + fr) * 8;
        const bf16_t* gt = gates + gate_tile_off(u.pm, gtile + u.pn) + wl;
        const size_t mtile = ((size_t)u.pm * 16 + u.pn) * 65536 + wl;
        bf16_t* mz = MB + (size_t)u.z * NR * 4096 + mtile;
        const bf16_t* m0 = MB + mtile; const bf16_t* m1 = MB + (size_t)NR * 4096 + mtile;
#pragma unroll
        for (int ab = 0; ab < 4; ++ab) { const int ai = ab >> 1, mb = (ab & 1) * 2;
            u32x4 gw[2][2], ca[2][2], cf[2][2];
#pragma unroll
            for (int mi = 0; mi < 2; ++mi)
#pragma unroll
                for (int bj = 0; bj < 2; ++bj) { const size_t po = (size_t)(((ai * 4 + mb + mi) * 2 + bj) * 4096);
                    gw[mi][bj] = *(const u32x4*)(gt + po);
                    if (MODE == 2) { ca[mi][bj] = *(const u32x4*)(m0 + po); cf[mi][bj] = *(const u32x4*)(m1 + po); } }
            asm volatile("" ::: "memory");
#pragma unroll
            for (int mi = 0; mi < 2; ++mi) { const int m = mb + mi; const size_t row = (size_t)(row0 + ai * HALF + m * 16);
#pragma unroll
                for (int bj = 0; bj < 2; ++bj) { const int col = col0 + bj * HALF; const u32x4 g = gw[mi][bj];
                    const f32x4 g0 = (f32x4){bflo(g.x), bfhi(g.x), bflo(g.y), bfhi(g.y)}, g1 = (f32x4){bflo(g.z), bfhi(g.z), bflo(g.w), bfhi(g.w)};
                    f32x4 v0 = acc[ai][bj][m][0] * g0, v1 = acc[ai][bj][m][1] * g1;
                    if (MODE == 2) { const u32x4 a_ = ca[mi][bj], f_ = cf[mi][bj];
                        v0 += (f32x4){bflo(a_.x), bfhi(a_.x), bflo(a_.y), bfhi(a_.y)} + (f32x4){bflo(f_.x), bfhi(f_.x), bflo(f_.y), bfhi(f_.y)};
                        v1 += (f32x4){bflo(a_.z), bfhi(a_.z), bflo(a_.w), bfhi(a_.w)} + (f32x4){bflo(f_.z), bfhi(f_.z), bflo(f_.w), bfhi(f_.w)}; }
                    u32x4 w; w.x = pkbf(v0[0], v0[1]); w.y = pkbf(v0[2], v0[3]); w.z = pkbf(v1[0], v1[1]); w.w = pkbf(v1[2], v1[3]);
                    if (MODE == 2) *(u32x4*)(OUT + row * 4096 + col) = w;
                    else *(u32x4*)(mz + (size_t)(((ai * 4 + m) * 2 + bj) * 4096)) = w; } }
        }
    }
};
}

struct Args { const float* in[29]; float* out; unsigned char* ws; int ph_lo, ph_hi; };
typedef const __attribute__((address_space(4))) Args* ArgP;
__device__ __forceinline__ ArgP get_args() { ArgP p = (ArgP)__builtin_amdgcn_kernarg_segment_ptr(); asm volatile("" : "+s"(p)); return p; }
enum { I_X = 0, I_C, I_CTX, I_CCTX, I_GMIXPRE, I_GMIXPOST, I_GMLPPRE, I_GMLPPOST, I_WMODA, I_WMODB, I_BMOD, I_WIN, I_CONVW, I_CONVB, I_CLNG, I_CLNB,
       I_QNG, I_WUQ, I_KVNG, I_WUKV, I_WPF, I_WPC, I_WPM, I_WGA, I_WGB, I_BGATE, I_WOUT, I_WFF1, I_WFF2 };

template <bool KVPERM>
__device__ __forceinline__ void transpose_item(const float* W, int N, bf16_t* WT, int ldo, int row_off, LAS float* scr, int item, int lane) {
    const int nblk = N / 32, kb = item / nblk, nb = item % nblk, k0 = 64 * kb, n0 = 32 * nb;
    float wv[32];
#pragma unroll
    for (int i = 0; i < 32; ++i) { const int kk = 2 * i + (lane >> 5); wv[i] = __builtin_nontemporal_load(W + (size_t)(k0 + kk) * N + n0 + (lane & 31)); }
    asm volatile("" ::: "memory");
#pragma unroll
    for (int i = 0; i < 32; ++i) { const int kk = 2 * i + (lane >> 5); scr[kk * 33 + (lane & 31)] = wv[i]; }
    LDS_WAIT();
    const int c = lane & 7;
#pragma unroll
    for (int j = 0; j < 4; ++j) { const int n = (lane >> 3) + 8 * j; const LAS float* s = scr + (8 * c) * 33 + n;
        u32x4 o; o.x = pk2(s[0 * 33], s[1 * 33]); o.y = pk2(s[2 * 33], s[3 * 33]); o.z = pk2(s[4 * 33], s[5 * 33]); o.w = pk2(s[6 * 33], s[7 * 33]);
        int orow = row_off + n0 + n; if (KVPERM) { const int nn = n0 + n; orow = ((nn & 128) ? 2048 : 0) + (nn >> 8) * 128 + (nn & 127); }
        *(u32x4*)(WT + (size_t)orow * ldo + k0 + 8 * c) = o; }
    LDS_WAIT();
}
template <bool KVPERM = false>
__device__ __forceinline__ void transpose_matrix(const float* W, int K, int N, bf16_t* WT, int ldo, int row_off, LAS float* scr, int gw, int NGW, int lane, int first_item = 0) {
    const int items = (K / 64) * (N / 32);
    for (int it = first_item + gw; it < items; it += NGW) transpose_item<KVPERM>(W, N, WT, ldo, row_off, scr, it, lane);
}

constexpr int DEF_PER_WAVE = 32, DEF_WAVES = 192 * 8, DEF_ITEMS = DEF_PER_WAVE * DEF_WAVES;
constexpr int W1_ITEMS = (4096 / 64) * (DFF / 32), DEF_W1 = DEF_ITEMS < W1_ITEMS ? DEF_ITEMS : W1_ITEMS, DEF_W2 = DEF_ITEMS - DEF_W1;
__device__ __forceinline__ void phase_pro0(ArgP a, LAS unsigned char* lds, int tid, int lane, int wave) {
    unsigned char* ws = a->ws;
    const int G = gridDim.x, gw = blockIdx.x * 8 + wave, NGW = G * 8;
    if (blockIdx.x < 32) {
        LAS float* sc = (LAS float*)lds;
        LAS float* red = sc + 5 * 4096;
        for (int i = tid; i < 5 * 4096; i += 512) { const int r = i >> 12, k = i & 4095; const float v = (r < 4) ? a->in[I_C][r * 4096 + k] : a->in[I_CCTX][k]; sc[i] = v * sigmoidf_(v); }
        __syncthreads();
        const int l = blockIdx.x >> 3, jc = blockIdx.x & 7, kg = tid >> 5, j = tid & 31;
        const float* wa = a->in[I_WMODA] + (size_t)l * 4096 * 256 + jc * 32 + j;
        float acc[5] = {0.f, 0.f, 0.f, 0.f, 0.f};
        for (int k = kg; k < 4096; k += 16) { const float w = wa[(size_t)k * 256];
#pragma unroll
            for (int r = 0; r < 5; ++r) acc[r] += sc[r * 4096 + k] * w; }
#pragma unroll
        for (int r = 0; r < 5; ++r) red[(kg * 5 + r) * 32 + j] = acc[r];
        __syncthreads();
        if (tid < 160) { const int r = tid >> 5, jj = tid & 31; float s = 0.f; for (int q = 0; q < 16; ++q) s += red[(q * 5 + r) * 32 + jj];
            ((float*)(ws + WS_A1))[(l * 5 + r) * 256 + jc * 32 + jj] = s; }
        __syncthreads();
    }
    {
        bf16_t* dx = (bf16_t*)(ws + WS_DFTX);
        const float nx = 0.022097086912079608f;
        for (int i = blockIdx.x * 512 + tid; i < 2048 * 2048 / 8; i += G * 512) { const int r = i / 256, n0 = (i % 256) * 8; const int pq = r > 1024 ? 1 : 0, k = r - 1024 * pq;
            unsigned w[4];
#pragma unroll
            for (int e = 0; e < 8; e += 2) { const int p0 = (k * (n0 + e)) & 2047, p1 = (k * (n0 + e + 1)) & 2047;
                const float a0 = (float)p0 * (1.0f / 2048.0f), a1 = (float)p1 * (1.0f / 2048.0f);
                const float t0 = pq ? __builtin_amdgcn_sinf(a0) : __builtin_amdgcn_cosf(a0), t1 = pq ? __builtin_amdgcn_sinf(a1) : __builtin_amdgcn_cosf(a1);
                w[e / 2] = pk2(t0 * nx, t1 * nx); }
            *(u32x4*)(dx + (size_t)r * 2048 + n0) = (u32x4){w[0], w[1], w[2], w[3]}; }
        bf16_t* dt = (bf16_t*)(ws + WS_DFTT);
        for (int i = blockIdx.x * 512 + tid; i < 512 * 256; i += G * 512) { const int r = i / 256, n = i % 256, k = r & 255, pq = r >> 8; float s, c;
            sincospif((float)((k * n) & 255) * (1.0f / 128.0f), &s, &c); dt[i] = (bf16_t)f2bf((pq ? s : c) * 0.0625f); }
        bf16_t* dc = (bf16_t*)(ws + WS_DFTC);
        for (int i = blockIdx.x * 512 + tid; i < 256 * 512; i += G * 512) { const int k2 = i / 512, q = i % 512, pq = q >> 8, cc = q & 255; float s, c;
            sincospif((float)((k2 * cc) & 255) * (1.0f / 128.0f), &s, &c); dc[i] = (bf16_t)f2bf((pq ? -s : c) * 0.0625f); }
        float* rt = (float*)(ws + WS_ROPE);
        for (int i = blockIdx.x * 512 + tid; i < 64 * 16; i += G * 512) { const int pos = i / 16, f = i % 16; const float inv = powf(10000.0f, -(float)f / 16.0f); const float ang = (float)pos * inv;
            rt[2 * i] = cosf(ang); rt[2 * i + 1] = sinf(ang); }
    }
    LAS float* scr = (LAS float*)(lds + wave * 16384);
    for (int l = 0; l < DEPTH; ++l) {
        unsigned char* wl = ws + WS_W + (size_t)l * LW;
        transpose_matrix(a->in[I_WIN] + (size_t)l * 4096 * DIN, 4096, DIN, (bf16_t*)(wl + OW_IN), 4096, 0, scr, gw, NGW, lane);
        transpose_matrix(a->in[I_WGA] + (size_t)l * 4096 * 512, 4096, 512, (bf16_t*)(wl + OW_IN), 4096, U_GA, scr, gw, NGW, lane);
        { u32x4* z = (u32x4*)((bf16_t*)(wl + OW_IN) + (size_t)U_END * 4096); for (int i = blockIdx.x * 512 + tid; i < (NU - U_END) * 4096 / 8; i += G * 512) z[i] = (u32x4){0u, 0u, 0u, 0u}; }
        transpose_matrix(a->in[I_WUQ] + (size_t)l * 1024 * 3072, 1024, 3072, (bf16_t*)(wl + OW_UQ), 1024, 0, scr, gw, NGW, lane);
        transpose_matrix<true>(a->in[I_WUKV] + (size_t)l * 512 * 4096, 512, 4096, (bf16_t*)(wl + OW_UKV), 512, 0, scr, gw, NGW, lane);
        transpose_matrix(a->in[I_WPF] + (size_t)l * 1024 * 4096, 1024, 4096, (bf16_t*)(wl + OW_PF), 1024, 0, scr, gw, NGW, lane);
        transpose_matrix(a->in[I_WPC] + (size_t)l * 1024 * 4096, 1024, 4096, (bf16_t*)(wl + OW_PC), 1024, 0, scr, gw, NGW, lane);
        transpose_matrix(a->in[I_WPM] + (size_t)l * 2048 * 4096, 2048, 4096, (bf16_t*)(wl + OW_PM), 2048, 0, scr, gw, NGW, lane);
        transpose_matrix(a->in[I_WGB] + (size_t)l * 512 * 12288, 512, 12288, (bf16_t*)(wl + OW_GB), 512, 0, scr, gw, NGW, lane);
        transpose_matrix(a->in[I_WOUT] + (size_t)l * 4096 * 4096, 4096, 4096, (bf16_t*)(wl + OW_OUT), 4096, 0, scr, gw, NGW, lane);
        transpose_matrix(a->in[I_WFF1] + (size_t)l * 4096 * DFF, 4096, DFF, (bf16_t*)(wl + OW_1), 4096, 0, scr, gw, NGW, lane, (l > 0 && gridDim.x == 256) ? DEF_W1 : 0);
        transpose_matrix(a->in[I_WFF2] + (size_t)l * DFF * 4096, DFF, 4096, (bf16_t*)(wl + OW_2), DFF, 0, scr, gw, NGW, lane, (l > 0 && gridDim.x == 256) ? DEF_W2 : 0);
    }
}
__device__ __forceinline__ void phase_pro1(ArgP a, LAS unsigned char* lds, int tid) {
    LAS float* a1s = (LAS float*)lds;
    for (int t0 = blockIdx.x * 512; t0 < DEPTH * 24576; t0 += gridDim.x * 512) {
        const int l = t0 / 24576;
        __syncthreads();
        for (int i = tid; i < 5 * 256; i += 512) a1s[i] = ((const float*)(a->ws + WS_A1))[l * 1280 + i];
        __syncthreads();
        const int j = (t0 + tid) % 24576;
        const float* wb = a->in[I_WMODB] + (size_t)l * 256 * 24576 + j;
        const float b = a->in[I_BMOD][l * 24576 + j];
        float acc[5] = {b, b, b, b, b};
        for (int k = 0; k < 256; ++k) { const float w = wb[(size_t)k * 24576];
#pragma unroll
            for (int r = 0; r < 5; ++r) acc[r] += a1s[r * 256 + k] * w; }
#pragma unroll
        for (int r = 0; r < 5; ++r) ((float*)(a->ws + WS_MODS))[((size_t)l * 5 + r) * 24576 + j] = acc[r];
    }
}
#define RCOL(j) (8 * (lane + 64 * ((j) >> 1)) + 4 * ((j) & 1))
__device__ __forceinline__ void modulate_store(const f32x4 (&v)[16], const float* g, const float* shift, const float* scale, bf16_t* orow, int lane) {
    float ss = 0.f;
#pragma unroll
    for (int j = 0; j < 16; ++j) ss += (v[j][0] * v[j][0] + v[j][1] * v[j][1]) + (v[j][2] * v[j][2] + v[j][3] * v[j][3]);
    const float r = rsqrtf(wave_sum(ss) * (1.0f / 4096.0f) + EPS);
#pragma unroll
    for (int j2 = 0; j2 < 8; ++j2) { u32x4 w;
#pragma unroll
        for (int e = 0; e < 2; ++e) { const int j = 2 * j2 + e, c = RCOL(j);
            const f32x4 gv = *(const f32x4*)(g + c), sh = *(const f32x4*)(shift + c), sc = *(const f32x4*)(scale + c);
            const f32x4 o = (v[j] * r) * gv * (sc + 1.0f) + sh;
            if (e == 0) { w.x = pkbf(o[0], o[1]); w.y = pkbf(o[2], o[3]); } else { w.z = pkbf(o[0], o[1]); w.w = pkbf(o[2], o[3]); } }
        *(u32x4*)(orow + RCOL(2 * j2)) = w; }
}
__device__ __forceinline__ const float* mods_row(ArgP a, int l, int row) { const int mb = row < NX ? (row >> 11) : 4; return (const float*)(a->ws + WS_MODS) + ((size_t)l * 5 + mb) * 24576; }
__device__ __forceinline__ void phase_pro2(ArgP a, int lane, int wave) {
    const int gw = blockIdx.x * 8 + wave, NGW = gridDim.x * 8;
    for (int row = gw; row < NR; row += NGW) {
        const float* src = row < NX ? a->in[I_X] + (size_t)row * 4096 : a->in[I_CTX] + (size_t)(row - NX) * 4096;
        f32x4 v[16];
#pragma unroll
        for (int j = 0; j < 16; ++j) v[j] = *(const f32x4*)(src + RCOL(j));
        const float* md = mods_row(a, 0, row);
        modulate_store(v, a->in[I_GMIXPRE], md, md + 4096, (bf16_t*)(a->ws + WS_H) + (size_t)row * 4096, lane);
    }
}
__device__ __forceinline__ void residual_row(ArgP a, int l, int which, int row, bool final_out, const LAS float* vg, int lane) {
    const bool from_input = (l == 0 && which == 0);
    const float* src = row < NX ? a->in[I_X] + (size_t)row * 4096 : a->in[I_CTX] + (size_t)(row - NX) * 4096;
    bf16_t* resrow = (bf16_t*)(a->ws + WS_RES) + (size_t)row * 4096;
    f32x4 v[16]; float ss = 0.f;
    if (row < NX) {
        const bf16_t* yrow = (const bf16_t*)(a->ws + WS_Y) + (size_t)row * 4096;
#pragma unroll
        for (int j2 = 0; j2 < 8; ++j2) { const u32x4 w = *(const u32x4*)(yrow + RCOL(2 * j2));
            v[2 * j2] = (f32x4){bflo(w.x), bfhi(w.x), bflo(w.y), bfhi(w.y)}; v[2 * j2 + 1] = (f32x4){bflo(w.z), bfhi(w.z), bflo(w.w), bfhi(w.w)}; }
    } else {
        const float* ys = (const float*)(a->ws + WS_YS) + (size_t)(row - NX) * 4096;
#pragma unroll
        for (int j = 0; j < 16; ++j) { const int c = RCOL(j);
            v[j] = (*(const f32x4*)(ys + c) + *(const f32x4*)(ys + (size_t)NT * 4096 + c)) + (*(const f32x4*)(ys + (size_t)2 * NT * 4096 + c) + *(const f32x4*)(ys + (size_t)3 * NT * 4096 + c));
            if ((j & 3) == 3) asm volatile("" ::: "memory"); }
    }
#pragma unroll
    for (int j = 0; j < 16; ++j) ss += (v[j][0] * v[j][0] + v[j][1] * v[j][1]) + (v[j][2] * v[j][2] + v[j][3] * v[j][3]);
    const float r = rsqrtf(wave_sum(ss) * (1.0f / 4096.0f) + EPS);
    if (from_input) {
#pragma unroll
        for (int j = 0; j < 16; ++j) { const int c = RCOL(j);
            v[j] = *(const f32x4*)(src + c) + *(const LAS f32x4*)(vg + 4096 + c) * ((v[j] * r) * *(const LAS f32x4*)(vg + c));
            if ((j & 3) == 3) asm volatile("" ::: "memory"); }
    } else {
#pragma unroll
        for (int j2 = 0; j2 < 8; ++j2) { const u32x4 w = *(const u32x4*)(resrow + RCOL(2 * j2));
            const f32x4 x0 = (f32x4){bflo(w.x), bfhi(w.x), bflo(w.y), bfhi(w.y)}, x1 = (f32x4){bflo(w.z), bfhi(w.z), bflo(w.w), bfhi(w.w)};
            const int c0 = RCOL(2 * j2), c1 = RCOL(2 * j2 + 1);
            v[2 * j2] = x0 + *(const LAS f32x4*)(vg + 4096 + c0) * ((v[2 * j2] * r) * *(const LAS f32x4*)(vg + c0));
            v[2 * j2 + 1] = x1 + *(const LAS f32x4*)(vg + 4096 + c1) * ((v[2 * j2 + 1] * r) * *(const LAS f32x4*)(vg + c1));
            if (j2 & 1) asm volatile("" ::: "memory"); }
    }
    if (final_out) {
#pragma unroll
        for (int j = 0; j < 16; ++j) *(f32x4*)(a->out + (size_t)row * 4096 + RCOL(j)) = v[j];
    } else {
#pragma unroll
        for (int j2 = 0; j2 < 8; ++j2) { u32x4 w; w.x = pkbf(v[2 * j2][0], v[2 * j2][1]); w.y = pkbf(v[2 * j2][2], v[2 * j2][3]); w.z = pkbf(v[2 * j2 + 1][0], v[2 * j2 + 1][1]); w.w = pkbf(v[2 * j2 + 1][2], v[2 * j2 + 1][3]);
            *(u32x4*)(resrow + RCOL(2 * j2)) = w; }
        float s2 = 0.f;
#pragma unroll
        for (int j = 0; j < 16; ++j) s2 += (v[j][0] * v[j][0] + v[j][1] * v[j][1]) + (v[j][2] * v[j][2] + v[j][3] * v[j][3]);
        const float r2 = rsqrtf(wave_sum(s2) * (1.0f / 4096.0f) + EPS);
        bf16_t* orow = (bf16_t*)(a->ws + WS_H) + (size_t)row * 4096;
#pragma unroll
        for (int j2 = 0; j2 < 8; ++j2) { u32x4 w;
#pragma unroll
            for (int e = 0; e < 2; ++e) { const int j = 2 * j2 + e, c = RCOL(j);
                const f32x4 o = (v[j] * r2) * *(const LAS f32x4*)(vg + 2 * 4096 + c) * (*(const LAS f32x4*)(vg + 4 * 4096 + c) + 1.0f) + *(const LAS f32x4*)(vg + 3 * 4096 + c);
                if (e == 0) { w.x = pkbf(o[0], o[1]); w.y = pkbf(o[2], o[3]); } else { w.z = pkbf(o[0], o[1]); w.w = pkbf(o[2], o[3]); } }
            *(u32x4*)(orow + RCOL(2 * j2)) = w;
            if (j2 & 1) asm volatile("" ::: "memory"); }
    }
}
__device__ __forceinline__ void residual_fill(ArgP a, int l, int which, int mb, bool final_out, LAS float* vg, int tid) {
    const float* gpost = a->in[which == 0 ? I_GMIXPOST : I_GMLPPOST] + l * 4096;
    const float* md = (const float*)(a->ws + WS_MODS) + ((size_t)l * 5 + mb) * 24576;
    const float* gate = md + (which == 0 ? 2 : 5) * 4096;
    const float* g2; const float* sh; const float* sc;
    if (which == 0) { g2 = a->in[I_GMLPPRE] + l * 4096; sh = md + 3 * 4096; sc = md + 4 * 4096; }
    else { const int l2 = final_out ? l : l + 1; const float* md2 = (const float*)(a->ws + WS_MODS) + ((size_t)l2 * 5 + mb) * 24576; g2 = a->in[I_GMIXPRE] + l2 * 4096; sh = md2; sc = md2 + 4096; }
#pragma unroll
    for (int k = 0; k < 2; ++k) { const int c = 4 * (tid + 512 * k);
        *(LAS f32x4*)(vg + c) = *(const f32x4*)(gpost + c); *(LAS f32x4*)(vg + 4096 + c) = *(const f32x4*)(gate + c);
        if (!final_out) { *(LAS f32x4*)(vg + 2 * 4096 + c) = *(const f32x4*)(g2 + c); *(LAS f32x4*)(vg + 3 * 4096 + c) = *(const f32x4*)(sh + c); *(LAS f32x4*)(vg + 4 * 4096 + c) = *(const f32x4*)(sc + c); } }
}
__device__ __forceinline__ void phase_residual(ArgP a, int l, int which, LAS unsigned char* lds, int tid, int lane, int wave) {
    const int G = gridDim.x;
    const bool lastl = (l == DEPTH - 1); const bool final_out = lastl && which == 1;
    LAS float* vg = (LAS float*)lds;
    const int bpb = G / NB;
    const int rpb = SEQ / bpb;
    {
        const int mb = blockIdx.x / bpb, r0 = mb * SEQ + (blockIdx.x % bpb) * rpb;
        residual_fill(a, l, which, mb, final_out, vg, tid);
        __syncthreads();
#pragma unroll 1
        for (int i = wave; i < rpb; i += 8) residual_row(a, l, which, r0 + i, final_out, vg, lane);
    }
    if (!lastl) {
        __syncthreads();
        residual_fill(a, l, which, 4, false, vg, tid);
        __syncthreads();
        if (wave < 4)
#pragma unroll 1
        for (int row = NX + blockIdx.x * 4 + wave; row < NR; row += G * 4) residual_row(a, l, which, row, false, vg, lane);
    }
    __syncthreads();
}
__device__ __forceinline__ void phase_postu(ArgP a, int l, LAS unsigned char* lds, int tid, int lane, int wave) {
    const int G = gridDim.x, gw = blockIdx.x * 8 + wave, NGW = G * 8;
    const bf16_t* U = (const bf16_t*)(a->ws + WS_U);
    {
        LAS float* red = (LAS float*)lds;
        const int c = 2 * tid;
        const float* cw = a->in[I_CONVW] + (size_t)l * 31 * 1024 + c;
        f32x2 wj[31];
#pragma unroll
        for (int j = 0; j < 31; ++j) wj[j] = *(const f32x2*)(cw + j * 1024);
        const f32x2 cb = *(const f32x2*)(a->in[I_CONVB] + l * 1024 + c), lg = *(const f32x2*)(a->in[I_CLNG] + l * 1024 + c), lb = *(const f32x2*)(a->in[I_CLNB] + l * 1024 + c);
        const int nconv = (l == DEPTH - 1 ? NX : NR) / 16;
        for (int it = blockIdx.x; it < nconv; it += G) {
            const int row0 = it * 16; int s0, L;
            if (row0 < NX) { s0 = row0 & ~2047; L = 2048; } else { s0 = NX + ((row0 - NX) & ~255); L = 256; }
            const int n0 = row0 - s0;
            f32x2 acc[16];
#pragma unroll
            for (int o = 0; o < 16; ++o) acc[o] = (f32x2){0.f, 0.f};
#pragma unroll
            for (int hf = 0; hf < 2; ++hf) {
                unsigned aw[23], gwd[23];
#pragma unroll
                for (int ii = 0; ii < 23; ++ii) { const int nn = n0 + hf * 23 + ii - 15; const int nc = nn < 0 ? 0 : (nn >= L ? L - 1 : nn);
                    const bf16_t* up = U + (size_t)(s0 + nc) * NU + c; aw[ii] = *(const unsigned*)(up + U_CA); gwd[ii] = *(const unsigned*)(up + U_CG); }
                asm volatile("" ::: "memory");
#pragma unroll
                for (int ii = 0; ii < 23; ++ii) { const int i = hf * 23 + ii; const int nn = n0 + i - 15; const float msk = (nn >= 0 && nn < L) ? 1.0f : 0.0f;
                    const f32x2 v = (f32x2){bflo(aw[ii]) * sigmoidf_(bflo(gwd[ii])) * msk, bfhi(aw[ii]) * sigmoidf_(bfhi(gwd[ii])) * msk};
#pragma unroll
                    for (int o = 0; o < 16; ++o) { const int j = i - o; if (j >= 0 && j < 31) acc[o] += v * wj[j]; } }
            }
            float st[32];
#pragma unroll
            for (int o = 0; o < 16; ++o) { acc[o] += cb; st[o] = wave_sum(acc[o][0] + acc[o][1]); st[16 + o] = wave_sum(acc[o][0] * acc[o][0] + acc[o][1] * acc[o][1]); }
            __syncthreads();
            if (lane == 0) {
#pragma unroll
                for (int k = 0; k < 32; ++k) red[wave * 32 + k] = st[k]; }
            __syncthreads();
            if (tid < 32) { float t = 0.f;
#pragma unroll
                for (int w = 0; w < 8; ++w) t += red[w * 32 + tid];
                red[256 + tid] = t; }
            __syncthreads();
#pragma unroll
            for (int o = 0; o < 16; ++o) { const float mean = red[256 + o] * (1.0f / 1024.0f); const float var = fmaxf(red[256 + 16 + o] * (1.0f / 1024.0f) - mean * mean, 0.f);
                const float rstd = rsqrtf(var + EPS);
                const float o0 = (acc[o][0] - mean) * rstd * lg[0] + lb[0], o1 = (acc[o][1] - mean) * rstd * lg[1] + lb[1];
                *(unsigned*)((bf16_t*)(a->ws + WS_CACT) + (size_t)(row0 + o) * 1024 + c) = pkbf(o0 * sigmoidf_(o0), o1 * sigmoidf_(o1)); }
        }
    }
    {
        const float* qg = a->in[I_QNG] + l * 1024; const float* kg = a->in[I_KVNG] + l * 512; const float* rope = (const float*)(a->ws + WS_ROPE);
        f32x4 qgv[4], kgv[2];
#pragma unroll
        for (int j = 0; j < 2; ++j) { qgv[2 * j] = *(const f32x4*)(qg + 8 * (lane + 64 * j)); qgv[2 * j + 1] = *(const f32x4*)(qg + 8 * (lane + 64 * j) + 4); }
        kgv[0] = *(const f32x4*)(kg + 8 * lane); kgv[1] = *(const f32x4*)(kg + 8 * lane + 4);
        const bool skew = (G == 256) && (l != DEPTH - 1);
        const int gw2 = skew ? (blockIdx.x < 64 ? NR : (int)(blockIdx.x - 64) * 8 + wave) : gw, NGW2 = skew ? 192 * 8 : NGW;
#pragma unroll 1
        for (int row = gw2; row < NR; row += NGW2) {
            const bf16_t* up = U + (size_t)row * NU;
            const u32x4 wq0 = *(const u32x4*)(up + U_Q + 8 * lane), wq1 = *(const u32x4*)(up + U_Q + 8 * (lane + 64));
            const u32x4 wk = *(const u32x4*)(up + U_KV + 8 * lane);
            const float val = bf2f(up[U_KR + lane]), par = bf2f(up[U_KR + (lane ^ 16)]);
            const int n = row & 2047, axis = lane >> 5, half = (lane >> 4) & 1, f = lane & 15; const int pos = axis ? (n & 63) : (n >> 6);
            const float cs = rope[(pos * 16 + f) * 2], sn = rope[(pos * 16 + f) * 2 + 1];
            asm volatile("" ::: "memory");
            {
                float v[16];
                v[0] = bflo(wq0.x); v[1] = bfhi(wq0.x); v[2] = bflo(wq0.y); v[3] = bfhi(wq0.y); v[4] = bflo(wq0.z); v[5] = bfhi(wq0.z); v[6] = bflo(wq0.w); v[7] = bfhi(wq0.w);
                v[8] = bflo(wq1.x); v[9] = bfhi(wq1.x); v[10] = bflo(wq1.y); v[11] = bfhi(wq1.y); v[12] = bflo(wq1.z); v[13] = bfhi(wq1.z); v[14] = bflo(wq1.w); v[15] = bfhi(wq1.w);
                float ss = 0.f;
#pragma unroll
                for (int e = 0; e < 16; ++e) ss += v[e] * v[e];
                const float r = rsqrtf(wave_sum(ss) * (1.0f / 1024.0f) + EPS);
#pragma unroll
                for (int j = 0; j < 2; ++j) { const int c0 = 8 * (lane + 64 * j); const f32x4 g0 = qgv[2 * j], g1 = qgv[2 * j + 1];
                    u32x4 o; o.x = pkbf(v[8 * j] * r * g0[0], v[8 * j + 1] * r * g0[1]); o.y = pkbf(v[8 * j + 2] * r * g0[2], v[8 * j + 3] * r * g0[3]);
                    o.z = pkbf(v[8 * j + 4] * r * g1[0], v[8 * j + 5] * r * g1[1]); o.w = pkbf(v[8 * j + 6] * r * g1[2], v[8 * j + 7] * r * g1[3]);
                    *(u32x4*)((bf16_t*)(a->ws + WS_QIN) + (size_t)row * 1024 + c0) = o; }
            }
            {
                float v[8];
                v[0] = bflo(wk.x); v[1] = bfhi(wk.x); v[2] = bflo(wk.y); v[3] = bfhi(wk.y); v[4] = bflo(wk.z); v[5] = bfhi(wk.z); v[6] = bflo(wk.w); v[7] = bfhi(wk.w);
                float ss = 0.f;
#pragma unroll
                for (int e = 0; e < 8; ++e) ss += v[e] * v[e];
                const float r = rsqrtf(wave_sum(ss) * (1.0f / 512.0f) + EPS);
                const int c0 = 8 * lane; const f32x4 g0 = kgv[0], g1 = kgv[1];
                u32x4 o; o.x = pkbf(v[0] * r * g0[0], v[1] * r * g0[1]); o.y = pkbf(v[2] * r * g0[2], v[3] * r * g0[3]);
                o.z = pkbf(v[4] * r * g1[0], v[5] * r * g1[1]); o.w = pkbf(v[6] * r * g1[2], v[7] * r * g1[3]);
                *(u32x4*)((bf16_t*)(a->ws + WS_KVIN) + (size_t)row * 512 + c0) = o;
            }
            {
                float o = val;
                if (row < NX) o = half ? (val * cs + par * sn) : (val * cs - par * sn);
                ((bf16_t*)(a->ws + WS_KR))[(size_t)row * 64 + lane] = (bf16_t)f2bf(o);
            }
        }
    }
}
typedef float f32x16 __attribute__((ext_vector_type(16)));
#define MFMA32(a, b, c) __builtin_amdgcn_mfma_f32_32x32x16_bf16((a), (b), (c), 0, 0, 0)
constexpr int AT_KP = 400, AT_VP = 144, AT_KB = 64 * AT_KP, AT_VB = 128 * AT_VP, AT_STAGE = AT_KB + AT_VB;
static_assert(2 * AT_STAGE <= RING_BYTES, "attention LDS");
template <bool ISX>
__device__ __forceinline__ void attn_unit(ArgP a, LAS unsigned char* lds, int b, int h, int qb, int tid, int lane, int wave) {
    unsigned char* ws = a->ws;
    const bf16_t* Q = (const bf16_t*)(ws + WS_Q); const bf16_t* KN = (const bf16_t*)(ws + WS_KN); const bf16_t* KR = (const bf16_t*)(ws + WS_KR); const bf16_t* VT = (const bf16_t*)(ws + WS_VT);
    const int r = lane & 31, hh = lane >> 5;
    const int qrow = (ISX ? b * SEQ + qb * 256 : NX + b * CTXL) + wave * 32 + r;
    constexpr int NKT = ISX ? 36 : 4;
    bf16x8 qf[12];
    { const bf16_t* qp = Q + (size_t)qrow * 3072 + h * 192 + 8 * hh;
#pragma unroll
      for (int ks = 0; ks < 12; ++ks) qf[ks] = *(const bf16x8*)(qp + 16 * ks); }
    const int skey = tid >> 3, sch = tid & 7;
    u32x4 kst[3], vst[2];
#define AT_KROW0(kt) (ISX ? ((kt) < 32 ? b * SEQ + (kt) * 64 : NX + b * CTXL + ((kt) - 32) * 64) : (NX + b * CTXL + (kt) * 64))
    const unsigned vo_kn = (unsigned)(skey * 4096 + sch * 16), vo_kr = (unsigned)(skey * 128 + sch * 16), vo_vt = (unsigned)(skey * (NR * 2) + sch * 16);
    const char* const knb = (const char*)(KN + h * 128); const char* const krb = (const char*)KR; const char* const vtb = (const char*)(VT + (size_t)(h * 128) * NR);
#define AT_LOAD(kt) do { const int kr0_ = AT_KROW0(kt); \
        const char* kp_ = knb + (size_t)kr0_ * 4096; const char* rp_ = krb + (size_t)kr0_ * 128; const char* vp0_ = vtb + (size_t)kr0_ * 2; \
        kst[0] = *(const u32x4*)(kp_ + vo_kn); kst[1] = *(const u32x4*)(kp_ + 128 + vo_kn); kst[2] = *(const u32x4*)(rp_ + vo_kr); \
        vst[0] = *(const u32x4*)(vp0_ + vo_vt); vst[1] = *(const u32x4*)(vp0_ + (size_t)64 * NR * 2 + vo_vt); } while (0)
#define AT_WRITE(boff) do { LAS unsigned char* sb_ = lds + (boff); \
        _Pragma("unroll") for (int i = 0; i < 3; ++i) *(LAS u32x4*)(sb_ + skey * AT_KP + (sch + 8 * i) * 16) = kst[i]; \
        _Pragma("unroll") for (int i = 0; i < 2; ++i) { LAS unsigned char* vp_ = sb_ + AT_KB + (skey + 64 * i) * AT_VP + (sch >> 1) * 32 + (sch & 1) * 8; \
            *(LAS u32x2*)vp_ = (u32x2){vst[i].x, vst[i].y}; *(LAS u32x2*)(vp_ + 16) = (u32x2){vst[i].z, vst[i].w}; } } while (0)
    f32x16 o[4];
#pragma unroll
    for (int dt = 0; dt < 4; ++dt)
#pragma unroll
        for (int i = 0; i < 16; ++i) o[dt][i] = 0.f;
    float m = 0.f, l = 0.f;
    f32x16 s0, s1;
#define AT_S(boff) do { const LAS unsigned char* kb = lds + (boff); \
        { const float ni_ = -m; _Pragma("unroll") for (int i = 0; i < 16; ++i) { s0[i] = ni_; s1[i] = ni_; } }     \
        _Pragma("unroll") for (int ks = 0; ks < 12; ++ks) { \
            const bf16x8 a0 = *(const LAS bf16x8*)(kb + r * AT_KP + ks * 32 + hh * 16); \
            const bf16x8 a1 = *(const LAS bf16x8*)(kb + (32 + r) * AT_KP + ks * 32 + hh * 16); \
            s0 = MFMA32(a0, qf[ks], s0); s1 = MFMA32(a1, qf[ks], s1); \
            if ((ks & 3) == 3) __builtin_amdgcn_sched_barrier(0); } } while (0)
#define AT_MAX32(dst) do { float x0_ = s0[0], x1_ = s1[0];     \
        _Pragma("unroll") for (int i = 1; i < 16; ++i) { x0_ = fmaxf(x0_, s0[i]); x1_ = fmaxf(x1_, s1[i]); } \
        dst = fmaxf(x0_, x1_); dst = fmaxf(dst, __shfl_xor(dst, 32)); } while (0)
#define AT_SOFTMAX_PV(boff, FIRST) do { const LAS unsigned char* vb = lds + (boff) + AT_KB; const bool first_ = (FIRST); \
        { float mx_; AT_MAX32(mx_); \
            if (__any(mx_ > (first_ ? -3.0e38f : 6.0f))) { \
                const float up = first_ ? mx_ : fmaxf(mx_, 0.f); const float alpha = first_ ? 1.0f : __builtin_amdgcn_exp2f(-up); m += up; l *= alpha; \
                _Pragma("unroll") for (int i = 0; i < 16; ++i) { s0[i] -= up; s1[i] -= up; } \
                _Pragma("unroll") for (int dt = 0; dt < 4; ++dt) _Pragma("unroll") for (int i = 0; i < 16; ++i) o[dt][i] *= alpha; } } \
        float ls = 0.f; \
        _Pragma("unroll") for (int i = 0; i < 16; ++i) { s0[i] = __builtin_amdgcn_exp2f(s0[i]); s1[i] = __builtin_amdgcn_exp2f(s1[i]); ls += s0[i] + s1[i]; } \
        l += ls; \
        _Pragma("unroll") for (int gq = 0; gq < 4; ++gq) { \
            const int t = gq >> 1, sj = gq & 1; u32x4 pw; \
            if (t == 0) { pw.x = pkbf(s0[8 * sj + 0], s0[8 * sj + 1]); pw.y = pkbf(s0[8 * sj + 2], s0[8 * sj + 3]); pw.z = pkbf(s0[8 * sj + 4], s0[8 * sj + 5]); pw.w = pkbf(s0[8 * sj + 6], s0[8 * sj + 7]); } \
            else        { pw.x = pkbf(s1[8 * sj + 0], s1[8 * sj + 1]); pw.y = pkbf(s1[8 * sj + 2], s1[8 * sj + 3]); pw.z = pkbf(s1[8 * sj + 4], s1[8 * sj + 5]); pw.w = pkbf(s1[8 * sj + 6], s1[8 * sj + 7]); } \
            const bf16x8 pb = __builtin_bit_cast(bf16x8, pw); \
            _Pragma("unroll") for (int dt = 0; dt < 4; ++dt) { \
                const bf16x8 vfr = *(const LAS bf16x8*)(vb + (dt * 32 + r) * AT_VP + (2 * t + sj) * 32 + hh * 16); \
                o[dt] = MFMA32(vfr, pb, o[dt]); } \
            __builtin_amdgcn_sched_barrier(0); } } while (0)
    AT_LOAD(0); AT_WRITE(0);
    __syncthreads();
    for (int j = 0; j < NKT; ++j) {
        if (j + 1 < NKT) AT_LOAD(j + 1);
        const int bcur = (j & 1) * AT_STAGE;
        AT_S(bcur);
        AT_SOFTMAX_PV(bcur, j == 0);
        if (j + 1 < NKT) AT_WRITE(((j + 1) & 1) * AT_STAGE);
        __syncthreads();
    }
    l += __shfl_xor(l, 32);
    const float inv = 1.0f / l;
    bf16_t* op = (bf16_t*)(ws + WS_O) + (size_t)qrow * 2048 + h * 128 + 4 * hh;
#pragma unroll
    for (int dt = 0; dt < 4; ++dt)
#pragma unroll
        for (int g4 = 0; g4 < 4; ++g4) {
            u32x2 w; w.x = pkbf(o[dt][4 * g4] * inv, o[dt][4 * g4 + 1] * inv); w.y = pkbf(o[dt][4 * g4 + 2] * inv, o[dt][4 * g4 + 3] * inv);
            *(u32x2*)(op + dt * 32 + 8 * g4) = w; }
#undef AT_KROW0
#undef AT_LOAD
#undef AT_WRITE
#undef AT_S
#undef AT_MAX32
#undef AT_SOFTMAX_PV
}
__device__ __forceinline__ void phase_attn(ArgP a, int l, LAS unsigned char* lds, int tid, int lane, int wave) {
    const int G = gridDim.x;
    if (G == 256) {
        const int xcd = blockIdx.x & 7, slot = blockIdx.x >> 3;
        for (int i = 0; i < 2; ++i) { const int pair = xcd * 8 + i * 4 + (slot >> 3), qb = slot & 7; attn_unit<true>(a, lds, pair >> 4, pair & 15, qb, tid, lane, wave); }
    } else
    for (int u = blockIdx.x; u < NB * 16 * 8; u += G) { const int qb = u & 7, h = (u >> 3) & 15, b = u >> 7; attn_unit<true>(a, lds, b, h, qb, tid, lane, wave); }
    if (l != DEPTH - 1) for (int u = (int)((blockIdx.x + G / 2) % G); u < NB * 16; u += G) { const int h = u & 15, b = u >> 4; attn_unit<false>(a, lds, b, h, 0, tid, lane, wave); }
}

constexpr int NPRO = 3, NPL = 11, NPHASE = NPRO + DEPTH * NPL;

__global__ void __launch_bounds__(512, 2) fwd_kernel(Args a_unused) {
    extern __shared__ __attribute__((aligned(16))) unsigned char lds_raw[];
    LAS unsigned char* lds = (LAS unsigned char*)lds_raw;
    const int tid = threadIdx.x, lane = tid & 63, wave = __builtin_amdgcn_readfirstlane(tid >> 6);
    const int lo = get_args()->ph_lo, hi = get_args()->ph_hi;
    volatile LAS unsigned* MISC = (volatile LAS unsigned*)(lds + MISC_OFF);
    if (tid < 16) MISC[tid] = 0u;
    __syncthreads();
    XcdBarrier bar; bar.bar = (unsigned*)(get_args()->ws + WS_CTL) + CW_BAR; bar.x = 0; bar.st = MISC + 8;
    if (hi - lo > 1) bar = xcd_barrier_post((unsigned*)(get_args()->ws + WS_CTL) + CW_BAR, MISC + 8);
#ifndef ONLYP
#define ONLYP (-1)
#endif
#ifndef ONLYS
#define ONLYS (-1)
#endif
#define SUB(k) (ONLYS < 0 || ONLYS == (k))
#define EN(k) (ONLYP < 0 || ONLYP == (k))
#define INR(p) (lo <= (p) && (p) < hi)
#define RUN(p) (EN(p) && INR(p))
#define RUNL(j) (EN(NPRO + (j)) && INR(pb + (j)))
#define SEAM(p) do { if (INR(p) && INR((p) + 1)) xcd_barrier(bar); } while (0)
#ifndef DUPK
#define DUPK (-1)
#endif
#ifndef DUPS
#define DUPS (-1)
#endif
#define REP(k) for (int rep_ = 0; rep_ < ((DUPK == (k) && DUPS < 0) ? 2 : 1); ++rep_)
#define REPS(k, sidx) for (int reps_ = 0; reps_ < ((DUPK == (k) && DUPS == (sidx)) ? 2 : 1); ++reps_)
    const int G = gridDim.x, cid = blockIdx.x;
    if (RUN(0)) REP(0) { if (rep_) xcd_barrier(bar); const int t_ = fresh_tid(); phase_pro0(get_args(), lds, t_, t_ & 63, __builtin_amdgcn_readfirstlane(t_ >> 6)); }
    SEAM(0);
    if (RUN(1)) { const int t_ = fresh_tid(); phase_pro1(get_args(), lds, t_); }
    SEAM(1);
    if (RUN(2)) { const int t_ = fresh_tid(); phase_pro2(get_args(), t_ & 63, __builtin_amdgcn_readfirstlane(t_ >> 6)); }
    SEAM(2);
    for (int l = 0; l < DEPTH; ++l) {
        const int pb = NPRO + l * NPL;
        const bool lastl = (l == DEPTH - 1);
        const int nMq = lastl ? 32 : 36;
#pragma unroll 1
        for (int ph_ = 0; ph_ < NPL; ++ph_) {
            int ph = ph_; asm volatile("" : "+s"(ph));
            if (RUNL(ph)) {
                unsigned char* ws = get_args()->ws; unsigned char* wl = ws + WS_W + (size_t)l * LW; (void)wl;
                if (ph == 0 || ph == 2 || ph == 3 || ph == 6 || ph == 9) {
                    const int ncall = (ph == 2) ? 2 : 1;
#pragma unroll 1
                    for (int k_ = 0; k_ < ncall; ++k_) {
                        int kk = k_; asm volatile("" : "+s"(kk));
                        pg8::Gemm g; pg8::Order S; pg8::EpiBf16<0> E;
                        if (ph == 0) {
                            g = pg8::Gemm{(const bf16_t*)(ws + WS_H), (const bf16_t*)(wl + OW_IN) + (size_t)1024 * 4096, 4096, 4096, 4096, 0, 0};
                            S.init(36, (NU - 1024) / 256, 1, G, cid);
                            E = pg8::EpiBf16<0>{(bf16_t*)(ws + WS_U) + 1024, NU, nullptr, 0};
                        } else if (ph == 2) {
                            const bf16_t* kvin = (const bf16_t*)(ws + WS_KVIN); const bf16_t* wkv = (const bf16_t*)(wl + OW_UKV);
                            g = pg8::Gemm{kk ? wkv + (size_t)2048 * 512 : kvin, kk ? kvin : wkv, 512, 512, 512, 0, 0};
                            S.init(kk ? 8 : 36, kk ? 36 : 8, 1, G, (cid + G - (kk ? 128 : (lastl ? 160 : 176))) % G);
                            E = pg8::EpiBf16<0>{(bf16_t*)(ws + (kk ? WS_VT : WS_KN)), kk ? NR : 2048, nullptr, 0};
                        } else if (ph == 3) {
                            g = pg8::Gemm{(const bf16_t*)(ws + WS_G), (const bf16_t*)(ws + WS_DFTC), 2048, 512, 512, 512, 0};
                            S.init(nMq, 1, 4, G, cid);
                            E = pg8::EpiBf16<0>{(bf16_t*)(ws + WS_F), 1024, nullptr, 256};
                        } else {
                            const bool hf = (ph == 9); const int Kd = hf ? DFF : 4096;
                            g = pg8::Gemm{(const bf16_t*)(ws + (hf ? WS_HID : WS_MERGED)), (const bf16_t*)(wl + (hf ? OW_2 : OW_OUT)), Kd, Kd, Kd, 0, 0};
                            S.init(32, 16, 1, G, cid);
                            E = pg8::EpiBf16<0>{(bf16_t*)(ws + WS_Y), 4096, nullptr, 0};
                        }
                        pg8::gemm_phase(lds, g, S, E);
                    }
                }
                if (ph == 0) {
                    pg8::Gemm g{(const bf16_t*)(wl + OW_IN), (const bf16_t*)(ws + WS_H), 4096, 4096, 4096, 0, 0};
                    pg8::Order S; S.init(4, 36, 1, G, (cid + G - (36 * ((NU - 1024) / 256)) % G) % G);
                    pg8::EpiUfT E{(bf16_t*)(ws + WS_UFTX), (bf16_t*)(ws + WS_UFTT)};
                    pg8::gemm_phase(lds, g, S, E);
                }
                if (ph == 1) { const int t_ = fresh_tid(); phase_postu(get_args(), l, lds, t_, t_ & 63, __builtin_amdgcn_readfirstlane(t_ >> 6)); }
                if (ph == 2) {
#pragma unroll 1
                    for (int k_ = 0; k_ < (lastl ? 1 : 2); ++k_) {
                        int kk = k_; asm volatile("" : "+s"(kk));
                        pg8::Gemm g{(const bf16_t*)(ws + (kk ? WS_DFTT : WS_DFTX)), (const bf16_t*)(ws + (kk ? WS_UFTT : WS_UFTX)), kk ? 256 : 2048, kk ? 256 : 2048, kk ? 256 : 2048, 0, kk ? (size_t)1024 * 256 : (size_t)1024 * 2048};
                        pg8::Order S; S.init(kk ? 2 : 8, 4, 4, G, cid);
                        pg8::EpiSeqDft E{(bf16_t*)(ws + WS_G), kk ? 1 : 4, kk ? 256 : 2048, kk ? NX : 0, kk ? 0u : 1023u, kk ? 0 : 1};
                        pg8::gemm_phase(lds, g, S, E);
                    }
                    {
                        pg8::Gemm g{(const bf16_t*)(ws + WS_QIN), (const bf16_t*)(wl + OW_UQ), 1024, 1024, 1024, 0, 0};
                        pg8::Order S; S.init(nMq, 12, 1, G, (cid + G - (lastl ? 128 : 64)) % G);
                        if (G == 256) {
                            if (cid < 128) { S.c = cid; S.Lend = 128; }
                            else { S.c = 128 + ((cid - 128 + 128 - 80) & 127); S.G = 128; }
                        }
                        pg8::EpiQRope E{(bf16_t*)(ws + WS_Q), (const float*)(ws + WS_ROPE)};
                        pg8::gemm_phase(lds, g, S, E);
                    }
                }
                if (ph == 2 || (ph == 3 && G == 256)) {
                    pg8::Gemm g{(const bf16_t*)(ws + WS_U) + U_GA, (const bf16_t*)(wl + OW_GB), NU, 512, 512, 0, 0};
                    pg8::Order S; S.init(nMq, 48, 1, G, (cid + G - 128) % G);
                    if (G == 256) { const int nch = nMq * 4, tail = G - nch; if (ph == 2) S.Lend -= tail; else S.c = cid >= nch ? S.Lend - tail + (cid - nch) : S.Lend; }
                    pg8::EpiGatesImg E{(bf16_t*)(ws + WS_GATES), get_args()->in[I_BGATE] + (size_t)l * 12288};
                    pg8::gemm_phase(lds, g, S, E);
                }
                if (ph == 4) {
#pragma unroll 1
                    for (int part = 0; part < 3; ++part) {
                        int part_ = part; asm volatile("" : "+s"(part_));
                        if ((part_ == 0 && (cid & 1)) || (part_ == 2 && !(cid & 1))) { const int t_ = fresh_tid(); phase_attn(get_args(), l, lds, t_, t_ & 63, __builtin_amdgcn_readfirstlane(t_ >> 6)); }
                        if (part_ == 1) {
                            pg8::Gemm g{(const bf16_t*)(ws + WS_CACT), (const bf16_t*)(wl + OW_PC), 1024, 1024, 1024, (size_t)0, (size_t)0};
                            g.aZ = (size_t)0 - (size_t)((WS_CACT - WS_F) / 2); g.bZ = (size_t)0 - (size_t)((OW_PC - OW_PF) / 2);
                            pg8::Order S; S.init(nMq, 16, 2, G, cid);
                            pg8::EpiGate<0> E{(bf16_t*)(ws + WS_M1), (const bf16_t*)(ws + WS_GATES), nullptr};
                            pg8::gemm_phase(lds, g, S, E);
                        }
                    }
                }
                if (ph == 5) {
                    pg8::Gemm g{(const bf16_t*)(ws + WS_O), (const bf16_t*)(wl + OW_PM), 2048, 2048, 2048, 0, 0};
                    pg8::Order S; S.init(nMq, 16, 1, G, cid);
                    pg8::EpiGate<2> E{(bf16_t*)(ws + WS_M1), (const bf16_t*)(ws + WS_GATES), (bf16_t*)(ws + WS_MERGED)};
                    pg8::gemm_phase(lds, g, S, E);
                    if (!lastl && G == 256 && cid >= 64) {
                        const int t_ = fresh_tid(); const int ln_ = t_ & 63, wv_ = __builtin_amdgcn_readfirstlane(t_ >> 6);
                        const float* W1 = get_args()->in[I_WFF1] + (size_t)(l + 1) * 4096 * DFF; bf16_t* W1T = (bf16_t*)(ws + WS_W + (size_t)(l + 1) * LW + OW_1);
                        const float* W2 = get_args()->in[I_WFF2] + (size_t)(l + 1) * DFF * 4096; bf16_t* W2T = (bf16_t*)(ws + WS_W + (size_t)(l + 1) * LW + OW_2);
                        LAS float* scr = (LAS float*)(lds + wv_ * 16384); const int w0_ = (cid - 64) * 8 + wv_;
#pragma unroll 1
                        for (int i = 0; i < DEF_PER_WAVE; ++i) { const int c_ = w0_ + DEF_WAVES * i;
                            if (c_ < W1_ITEMS) transpose_item<false>(W1, DFF, W1T, 4096, 0, scr, c_, ln_); else transpose_item<false>(W2, 4096, W2T, DFF, 0, scr, c_ - W1_ITEMS, ln_); }
                    }
                }
                if ((ph == 6 || ph == 9) && !lastl) {
                    const bool hf = (ph == 9); const int Kd = hf ? DFF : 4096;
                    pg8::Gemm g{(const bf16_t*)(ws + (hf ? WS_HID : WS_MERGED)) + (size_t)NX * Kd, (const bf16_t*)(wl + (hf ? OW_2 : OW_OUT)), Kd, Kd, Kd / 4, (size_t)(Kd / 4), (size_t)(Kd / 4)};
                    pg8::Order S; S.init(4, 16, 4, G, (cid + G - (32 * 16) % G) % G);
                    pg8::EpiF32 E{(float*)(ws + WS_YS), 4096, (size_t)NT * 4096};
                    pg8::gemm_phase(lds, g, S, E);
                }
                if (ph == 7 || ph == 10) { const int t_ = fresh_tid(); phase_residual(get_args(), l, ph == 10 ? 1 : 0, lds, t_, t_ & 63, __builtin_amdgcn_readfirstlane(t_ >> 6)); }
                if (ph == 8) {
                    pg8::Gemm g{(const bf16_t*)(ws + WS_H), (const bf16_t*)(wl + OW_1), 4096, 4096, 4096, 0, 0};
                    pg8::Order S; S.init(nMq, 64, 1, G, cid);
                    pg8::EpiBf16<2> E{(bf16_t*)(ws + WS_HID), DFF, nullptr, 0};
                    pg8::gemm_phase(lds, g, S, E);
                }
            }
            SEAM(pb + ph);
        }
    }
#undef RUN
#undef RUNL
#undef SEAM
}

extern "C" void kernel_launch(void* const* d_in, const int* in_sizes, int n_in, void* d_out, int out_size, void* d_ws, size_t ws_size, hipStream_t stream) {
    static int grid = 0;
    if (grid == 0) {
        if (n_in != 29 || out_size != NX * DM || ws_size < WS_END) { fprintf(stderr, "kernel_launch: unexpected shapes (n_in %d out %d ws %zu need %zu)\n", n_in, out_size, ws_size, (size_t)WS_END); grid = -1; return; }
        int dev = 0, cus = 0, per_cu = 0;
        if (hipGetDevice(&dev) != hipSuccess || hipDeviceGetAttribute(&cus, hipDeviceAttributeMultiprocessorCount, dev) != hipSuccess) { grid = -1; return; }
        if (hipFuncSetAttribute((const void*)fwd_kernel, hipFuncAttributeMaxDynamicSharedMemorySize, LDS_BYTES) != hipSuccess) { fprintf(stderr, "kernel_launch: hipFuncSetAttribute failed\n"); grid = -1; return; }
        if (hipOccupancyMaxActiveBlocksPerMultiprocessor(&per_cu, (const void*)fwd_kernel, 512, LDS_BYTES) != hipSuccess || per_cu < 1) { fprintf(stderr, "kernel_launch: occupancy query says %d\n", per_cu); }
        (void)hipGetLastError();
        if (cus < 256) { fprintf(stderr, "kernel_launch: built for a 256-CU device (got %d CUs)\n", cus); grid = -1; return; }
        grid = 256;
    }
    if (grid < 0) return;
    (void)hipMemsetAsync((char*)d_ws + WS_CTL, 0, CTL_BYTES, stream);
    Args a{};
    for (int i = 0; i < 29; ++i) a.in[i] = (const float*)d_in[i];
    a.out = (float*)d_out; a.ws = (unsigned char*)d_ws;
#if ONE_LAUNCH
    a.ph_lo = 0; a.ph_hi = NPHASE;
    hipLaunchKernelGGL(fwd_kernel, dim3(grid), dim3(512), LDS_BYTES, stream, a);
#else
    for (int p = 0; p < NPHASE; ++p) { a.ph_lo = p; a.ph_hi = p + 1; hipLaunchKernelGGL(fwd_kernel, dim3(grid), dim3(512), LDS_BYTES, stream, a); }
#endif
}
```

```cpp
#include <hip/hip_runtime.h>
#include <cstdio>

#ifndef ONE_LAUNCH
#define ONE_LAUNCH 1
#endif

#define LAS __attribute__((address_space(3)))
#define GAS __attribute__((address_space(1)))
typedef unsigned short bf16_t;
typedef short bf16x8 __attribute__((ext_vector_type(8)));
typedef float f32x4 __attribute__((ext_vector_type(4)));
typedef float f32x2 __attribute__((ext_vector_type(2)));
typedef unsigned u32x4 __attribute__((ext_vector_type(4)));
typedef unsigned u32x2 __attribute__((ext_vector_type(2)));

constexpr int DM = 4096, NB = 4, SEQ = 2048, CTXL = 256, DEPTH = 4;
constexpr int NX = NB * SEQ, NT = NB * CTXL, NR = NX + NT;
constexpr int NU = 5376;
constexpr int U_F = 0, U_CA = 1024, U_CG = 2048, U_Q = 3072, U_KV = 4096, U_KR = 4608, U_GA = 4672, U_END = 5184;
constexpr int DIN = 4672, DFF = 16384;
constexpr float EPS = 1e-6f;
constexpr float ATTN_SCALE = 0.07216878364870322f;
constexpr float QSCALE = 0.07216878364870322f * 1.4426950408889634f;

constexpr size_t MiB = 1ull << 20;
constexpr size_t WS_CTL = 0, CTL_BYTES = 32768;
constexpr size_t WS_W = 1 * MiB, LW = 384 * MiB;
constexpr size_t OW_IN = 0, OW_UQ = OW_IN + 5376ull * 4096 * 2, OW_UKV = OW_UQ + 3072ull * 1024 * 2, OW_PF = OW_UKV + 4096ull * 512 * 2,
                 OW_PC = OW_PF + 4096ull * 1024 * 2, OW_PM = OW_PC + 4096ull * 1024 * 2, OW_GB = OW_PM + 4096ull * 2048 * 2,
                 OW_OUT = OW_GB + 12288ull * 512 * 2, OW_1 = OW_OUT + 4096ull * 4096 * 2, OW_2 = OW_1 + 16384ull * 4096 * 2;
static_assert(OW_2 + 4096ull * 16384 * 2 == LW, "per-layer weight map");
constexpr size_t WS_DFTX = WS_W + 4 * LW;
constexpr size_t WS_DFTT = WS_DFTX + 16 * MiB;
constexpr size_t WS_DFTC = WS_DFTT + 1 * MiB;
constexpr size_t WS_ROPE = WS_DFTC + 1 * MiB;
constexpr size_t WS_A1 = WS_ROPE + 1 * MiB;
constexpr size_t WS_MODS = WS_A1 + 1 * MiB;
constexpr size_t WS_RES = WS_MODS + 2 * MiB;
constexpr size_t WS_H = WS_RES + 144 * MiB;
constexpr size_t WS_U = WS_H + 72 * MiB;
constexpr size_t WS_UFTX = WS_U + 95 * MiB;
constexpr size_t WS_UFTT = WS_UFTX + 16 * MiB;
constexpr size_t WS_G = WS_UFTT + 2 * MiB;
constexpr size_t WS_F = WS_G + 36 * MiB;
constexpr size_t WS_CACT = WS_F + 18 * MiB;
constexpr size_t WS_QIN = WS_CACT + 18 * MiB;
constexpr size_t WS_KVIN = WS_QIN + 18 * MiB;
constexpr size_t WS_KR = WS_KVIN + 9 * MiB;
constexpr size_t WS_Q = WS_KR + 2 * MiB;
constexpr size_t WS_KN = WS_Q + 54 * MiB;
constexpr size_t WS_VT = WS_KN + 36 * MiB;
constexpr size_t WS_O = WS_VT + 36 * MiB;
constexpr size_t WS_GATES = WS_O + 36 * MiB;
constexpr size_t WS_M1 = WS_GATES + 216 * MiB;
constexpr size_t WS_MERGED = WS_M1 + 144 * MiB;
constexpr size_t WS_Y = WS_MERGED + 72 * MiB;
constexpr size_t WS_HID = WS_Y + 144 * MiB;
constexpr size_t WS_YS = WS_HID + 288 * MiB;
constexpr size_t WS_END = WS_YS + 64 * MiB;

constexpr int CW_BAR = 4096;
static_assert((CW_BAR + 3456) * 4 <= (int)CTL_BYTES, "barrier words inside the per-call memset");

constexpr int RING_BYTES = 133120;
constexpr int MISC_OFF = RING_BYTES + 256;
constexpr int LDS_BYTES = 147456;

__device__ __forceinline__ float bf2f(unsigned b) { return __uint_as_float(b << 16); }
__device__ __forceinline__ float bflo(unsigned w) { return __uint_as_float(w << 16); }
__device__ __forceinline__ float bfhi(unsigned w) { return __uint_as_float(w & 0xffff0000u); }
__device__ __forceinline__ unsigned f2bf(float f) { unsigned u = __float_as_uint(f); return (u + 0x7fffu + ((u >> 16) & 1u)) >> 16; }
__device__ __forceinline__ unsigned pk2(float lo, float hi) { return f2bf(lo) | (f2bf(hi) << 16); }
typedef __bf16 bf16x2_t __attribute__((ext_vector_type(2)));
__device__ __forceinline__ unsigned pkbf(float lo, float hi) { const f32x2 v = {lo, hi}; return __builtin_bit_cast(unsigned, __builtin_convertvector(v, bf16x2_t)); }
__device__ __forceinline__ float sigmoidf_(float x) { return __builtin_amdgcn_rcpf(1.0f + __builtin_amdgcn_exp2f(-1.4426950408889634f * x)); }
__device__ __forceinline__ float wave_sum(float v) {
#pragma unroll
    for (int o = 1; o < 64; o <<= 1) v += __shfl_xor(v, o);
    return v;
}
__device__ __forceinline__ float wave_max(float v) {
#pragma unroll
    for (int o = 1; o < 64; o <<= 1) v = fmaxf(v, __shfl_xor(v, o));
    return v;
}
#define LDS_WAIT() asm volatile("s_waitcnt lgkmcnt(0)" ::: "memory")
__device__ __forceinline__ int fresh_tid() { int t = threadIdx.x; asm volatile("" : "+v"(t)); return t; }

#define XB_TMO      128
#define XB_XCNT(j)  (256  + 64 * (j))
#define XB_XSUB(j)  (1280 + 64 * (j))
#define XB_XGEN(j)  (2304 + 64 * (j))
#define XB_TOP      3328
#define XB_TOPGEN   3392
#define XCD_BAR_WORDS 3456
#define XB_SPIN_CAP (1u << 18)

__device__ __forceinline__ unsigned xb_ld(unsigned* p)              { return __hip_atomic_load(p, __ATOMIC_RELAXED, __HIP_MEMORY_SCOPE_AGENT); }
__device__ __forceinline__ unsigned xb_add(unsigned* p, unsigned v) { return __hip_atomic_fetch_add(p, v, __ATOMIC_RELAXED, __HIP_MEMORY_SCOPE_AGENT); }
__device__ __forceinline__ unsigned xb_xcc_id() { return (unsigned)__builtin_amdgcn_s_getreg((3 << 11) | 20) & 0xFu; }
#define XB_SPIN(cond, bar) do { unsigned _sp = 0; while (cond) { __builtin_amdgcn_s_sleep(1); \
    if ((++_sp & 255u) == 0u) { if (xb_ld(&(bar)[XB_TMO])) break; if (_sp > XB_SPIN_CAP) { atomicAdd(&(bar)[XB_TMO], 1u); break; } } } } while (0)

struct XcdBarrier { unsigned* bar; unsigned x; volatile LAS unsigned* st; };

__device__ __forceinline__ XcdBarrier xcd_barrier_post(unsigned* bar, volatile LAS unsigned* st) {
    XcdBarrier b; b.bar = bar; b.x = xb_xcc_id(); b.st = st;
    if (threadIdx.x == 0) (void)xb_add(&bar[XB_XCNT(b.x)], 1u);
    return b;
}
__device__ __forceinline__ void xcd_barrier_complete(unsigned* bar, unsigned x, unsigned& nloc, unsigned& nx) {
    const unsigned G = gridDim.x * gridDim.y * gridDim.z;
    unsigned sum, cnt, mine, sp = 0u;
    for (;;) {
        sum = 0u; cnt = 0u; mine = 0u;
#pragma unroll
        for (unsigned j = 0; j < 16; ++j) { const unsigned c = xb_ld(&bar[XB_XCNT(j)]); sum += c; cnt += (c > 0u) ? 1u : 0u; mine = (j == x) ? c : mine; }
        if (sum == G) break;
        __builtin_amdgcn_s_sleep(1);
        if ((++sp & 255u) == 0u) { if (xb_ld(&bar[XB_TMO])) break; if (sp > XB_SPIN_CAP) { atomicAdd(&bar[XB_TMO], 1u); break; } }
    }
    nloc = mine > 0u ? mine : 1u; nx = cnt > 0u ? cnt : 1u;
}
__device__ __forceinline__ void xcd_barrier(const XcdBarrier& b) {
    asm volatile("s_waitcnt vmcnt(0)" ::: "memory");
    __syncthreads();
    if (threadIdx.x == 0) {
        unsigned* bar = b.bar;
        __builtin_amdgcn_s_waitcnt(0);
        unsigned nloc = b.st[0], nx = b.st[1];
        if (nloc == 0u) { xcd_barrier_complete(bar, b.x, nloc, nx); b.st[0] = nloc; b.st[1] = nx; }
        const unsigned old = xb_add(&bar[XB_XSUB(b.x)], 1u);
        const unsigned gen = old / nloc;
        if (old + 1u == (gen + 1u) * nloc) {
            __builtin_amdgcn_fence(__ATOMIC_RELEASE, "agent");
            asm volatile("s_waitcnt vmcnt(0)" ::: "memory");
            const unsigned og = xb_add(&bar[XB_TOP], 1u);
            const unsigned tg = og / nx;
            if (og + 1u == (tg + 1u) * nx) xb_add(&bar[XB_TOPGEN], 1u);
            else XB_SPIN(xb_ld(&bar[XB_TOPGEN]) == tg, bar);
            __builtin_amdgcn_fence(__ATOMIC_ACQUIRE, "agent");
            xb_add(&bar[XB_XGEN(b.x)], 1u);
            asm volatile("s_waitcnt vmcnt(0)" ::: "memory");
        } else {
            XB_SPIN(xb_ld(&bar[XB_XGEN(b.x)]) == gen, bar);
            __builtin_amdgcn_fence(__ATOMIC_ACQUIRE, "agent");
            asm volatile("s_waitcnt vmcnt(0)" ::: "memory");
        }
    }
    __syncthreads();
}

namespace pg8 {
constexpr int BM = 256, BK = 64, HALF = 128, HTB = HALF * BK * 2, STAGE_BYTES = 8 * HTB, NXCD = 8, WGM = 4;
__host__ __device__ __forceinline__ int lds_byte(int r, int c) { const int st = (r >> 4) * 2 + (c >> 5), rr = r & 15, cc = c & 31, ob = rr * 64 + cc * 2; return st * 1024 + (ob ^ (((ob >> 9) & 1) << 5)); }
__host__ __device__ __forceinline__ void stage_rc(int b, int& R, int& C) { const int st = b / 1024, sb = b % 1024, swz = sb ^ (((sb >> 9) & 1) << 5); R = (st >> 1) * 16 + swz / 64; C = (st & 1) * 32 + (swz % 64) / 2; }
__host__ __device__ __forceinline__ int perm32(int rho) { const int n = rho >> 4, i = rho & 15; return 8 * (i >> 2) + 4 * n + (i & 3); }

struct Unit { int pm, pn, z; };
struct Gemm { const bf16_t* A; const bf16_t* Bt; int lda, ldb, K; size_t aZ, bZ; };

struct Order {
    int nM, nN, nwg, nZ, G, c, Lend, rev;
    __device__ __forceinline__ void init(int nM_, int nN_, int nZ_, int G_, int c_) { nM = nM_; nN = nN_; nwg = nM * nN; nZ = nZ_; G = G_; c = c_; Lend = nwg * nZ; rev = 0; }
    __device__ __forceinline__ bool next(int i, Unit& u) const {
        const int L = i * G + c; if (L >= Lend) return false;
        const int zz = (L >= nwg ? 1 : 0) + (L >= 2 * nwg ? 1 : 0) + (L >= 3 * nwg ? 1 : 0);
        u.z = zz; int wgid = L - zz * nwg;
        { const int q = nwg / NXCD, r = nwg % NXCD, xcd = wgid % NXCD, off = wgid / NXCD; wgid = (xcd < r ? xcd * (q + 1) : r * (q + 1) + (xcd - r) * q) + off; }
        const int nig = WGM * nN, gid = wgid / nig, fm = gid * WGM, gsz = (nM - fm) < WGM ? (nM - fm) : WGM;
        u.pm = fm + ((wgid % nig) % gsz); u.pn = (wgid % nig) / gsz; if (rev) u.pm = nM - 1 - u.pm; return true;
    }
};

template <bool ALIGN_EPI = true, bool SP2 = true, class Epi, class Sched>
__device__ __forceinline__ void gemm_phase(LAS unsigned char* lds, const Gemm g, const Sched& S, const Epi& E) {
    const int tid = fresh_tid(), wid = __builtin_amdgcn_readfirstlane(tid >> 6), lane = tid & 63, wr = wid >> 2, wc = wid & 3, fr = lane & 15, fq = lane >> 4;
    const int K = g.K, nt = K / BK;
    unsigned voffA[2], voffB[2];
#pragma unroll
    for (int i = 0; i < 2; ++i) { int R, C; stage_rc(tid * 16 + i * 8192, R, C); const int Rb = Epi::PERM ? ((R & ~31) + perm32(R & 31)) : R;
        voffA[i] = (unsigned)(R * g.lda + C) * 2u; voffB[i] = (unsigned)(Rb * g.ldb + C) * 2u; }
    const size_t kstep = (size_t)(BK * 2);
    const size_t hA = (size_t)HALF * g.lda * 2, hB = (size_t)HALF * g.ldb * 2;
    const unsigned ldsw = (unsigned)wid * 1024u;
    const int aoff = lds_byte(wr * 64 + fr, fq * 8), boff = lds_byte(wc * 32 + fr, fq * 8);
#define PG8_SA(b, h) (((b) * 2 + (h)) * HTB)
#define PG8_SB(b, h) ((4 + (b) * 2 + (h)) * HTB)
#define PG8_STAGE(bufoff, gbase, voff) do { _Pragma("unroll") for (int _i = 0; _i < 2; ++_i) \
        __builtin_amdgcn_global_load_lds((const unsigned*)((const char*)(gbase) + (voff)[_i]), (LAS unsigned*)(lds + (bufoff) + ldsw + _i * 8192), 16, 0, 0); } while (0)
#define PG8_LDA(dst, b, h) do { _Pragma("unroll") for (int m = 0; m < 4; ++m) _Pragma("unroll") for (int k = 0; k < 2; ++k) dst[m][k] = *(const LAS bf16x8*)(lds + PG8_SA(b, h) + aoff + m * 2048 + k * 1024); } while (0)
#define PG8_LDB(dst, b, h) do { _Pragma("unroll") for (int n = 0; n < 2; ++n) _Pragma("unroll") for (int k = 0; k < 2; ++k) dst[n][k] = *(const LAS bf16x8*)(lds + PG8_SB(b, h) + boff + n * 2048 + k * 1024); } while (0)
#define PG8_MMA(ai, bj, At, Bt) do { __builtin_amdgcn_s_setprio(1); _Pragma("unroll") for (int m = 0; m < 4; ++m) _Pragma("unroll") for (int n = 0; n < 2; ++n) _Pragma("unroll") for (int k = 0; k < 2; ++k) \
        acc[ai][bj][m][n] = __builtin_amdgcn_mfma_f32_16x16x32_bf16(Bt[n][k], At[m][k], acc[ai][bj][m][n], 0, 0, 0); __builtin_amdgcn_s_setprio(0); } while (0)
#define PG8_WAIT_V(n) asm volatile("s_waitcnt vmcnt(" #n ")" ::: "memory")
#define PG8_WAIT_L(n) asm volatile("s_waitcnt lgkmcnt(" #n ")" ::: "memory")
#define PG8_BAR __builtin_amdgcn_s_barrier()
#define PG8_SCHED __builtin_amdgcn_sched_barrier(0)
#define PG8_ABASE(u) ((const char*)g.A + ((size_t)(u).z * g.aZ + (size_t)(u).pm * BM * g.lda) * 2)
#define PG8_BBASE(u) ((const char*)g.Bt + ((size_t)(u).z * g.bZ + (size_t)(u).pn * BM * g.ldb) * 2)
    Unit cur, nxt; int ui = 0;
    if (!S.next(0, cur)) return;
    f32x4 acc[2][2][4][2];
#pragma unroll
    for (int a = 0; a < 2; ++a)
#pragma unroll
        for (int b = 0; b < 2; ++b)
#pragma unroll
            for (int m = 0; m < 4; ++m)
#pragma unroll
                for (int n = 0; n < 2; ++n) acc[a][b][m][n] = (f32x4){0.f, 0.f, 0.f, 0.f};
    bf16x8 At[4][2], B0[2][2], B1[2][2];
    const char* cA = PG8_ABASE(cur); const char* cB = PG8_BBASE(cur);
    if constexpr (SP2) {
        PG8_STAGE(PG8_SB(0, 0), cB, voffB); PG8_STAGE(PG8_SB(0, 1), cB + hB, voffB); PG8_STAGE(PG8_SA(0, 0), cA, voffA); PG8_STAGE(PG8_SA(0, 1), cA + hA, voffA);
        if (wr == 1) PG8_BAR;
        PG8_WAIT_V(2); PG8_BAR;
        PG8_STAGE(PG8_SB(1, 0), cB + kstep, voffB); PG8_STAGE(PG8_SA(1, 0), cA + kstep, voffA); PG8_STAGE(PG8_SB(1, 1), cB + hB + kstep, voffB);
        PG8_WAIT_V(6); PG8_BAR;
    } else {
        PG8_STAGE(PG8_SB(0, 0), cB, voffB); PG8_STAGE(PG8_SA(0, 0), cA, voffA); PG8_STAGE(PG8_SB(0, 1), cB + hB, voffB); PG8_STAGE(PG8_SA(0, 1), cA + hA, voffA);
        if (wr == 1) PG8_BAR;
        PG8_WAIT_V(4); PG8_BAR;
        PG8_STAGE(PG8_SB(1, 0), cB + kstep, voffB); PG8_STAGE(PG8_SA(1, 0), cA + kstep, voffA); PG8_STAGE(PG8_SB(1, 1), cB + hB + kstep, voffB);
        PG8_WAIT_V(6); PG8_BAR;
    }
    for (;;) {
        const bool has_next = S.next(ui + 1, nxt);
        const char* nA = has_next ? PG8_ABASE(nxt) : cA; const char* nB = has_next ? PG8_BBASE(nxt) : cB;
        for (int t = 0; t < nt; t += 2) {
            const bool last = (t == nt - 2);
            const char* a1 = cA + (size_t)(t + 1) * kstep;
            const char* a2 = last ? nA : cA + (size_t)(t + 2) * kstep; const char* b2 = last ? nB : cB + (size_t)(t + 2) * kstep;
            const char* a3 = a2 + kstep; const char* b3 = b2 + kstep;
            if constexpr (SP2) {
            PG8_LDB(B0, 0, 0); PG8_LDB(B1, 0, 1); PG8_SCHED; PG8_LDA(At, 0, 0); PG8_STAGE(PG8_SA(1, 1), a1 + hA, voffA);
            PG8_WAIT_V(8); PG8_WAIT_L(0); PG8_BAR; PG8_MMA(0, 0, At, B0); PG8_MMA(0, 1, At, B1); PG8_BAR; PG8_SCHED;
            PG8_LDA(At, 0, 1); PG8_STAGE(PG8_SB(0, 0), b2, voffB); PG8_STAGE(PG8_SB(0, 1), b2 + hB, voffB); PG8_STAGE(PG8_SA(0, 0), a2, voffA);
            PG8_WAIT_V(8); PG8_WAIT_L(0); PG8_BAR; PG8_MMA(1, 0, At, B0); PG8_MMA(1, 1, At, B1); PG8_BAR; PG8_SCHED;
            PG8_LDB(B0, 1, 0); PG8_LDB(B1, 1, 1); PG8_SCHED; PG8_LDA(At, 1, 0); PG8_STAGE(PG8_SA(0, 1), a2 + hA, voffA);
            PG8_WAIT_V(8); PG8_WAIT_L(0); PG8_BAR; PG8_MMA(0, 0, At, B0); PG8_MMA(0, 1, At, B1); PG8_BAR; PG8_SCHED;
            PG8_LDA(At, 1, 1); PG8_STAGE(PG8_SB(1, 0), b3, voffB); PG8_STAGE(PG8_SB(1, 1), b3 + hB, voffB); PG8_STAGE(PG8_SA(1, 0), a3, voffA);
            PG8_WAIT_V(8); PG8_WAIT_L(0); PG8_BAR; PG8_MMA(1, 0, At, B0); PG8_MMA(1, 1, At, B1); PG8_BAR; PG8_SCHED;
            } else {
            PG8_LDB(B0, 0, 0); PG8_SCHED; PG8_LDA(At, 0, 0); PG8_STAGE(PG8_SA(1, 1), a1 + hA, voffA);
            PG8_WAIT_L(8); PG8_BAR; PG8_WAIT_L(0); PG8_MMA(0, 0, At, B0); PG8_BAR; PG8_SCHED;
            PG8_LDB(B1, 0, 1); PG8_STAGE(PG8_SB(0, 0), b2, voffB);
            PG8_BAR; PG8_WAIT_L(0); PG8_MMA(0, 1, At, B1); PG8_BAR;
            PG8_LDA(At, 0, 1); PG8_STAGE(PG8_SA(0, 0), a2, voffA);
            PG8_BAR; PG8_WAIT_L(0); PG8_MMA(1, 0, At, B0); PG8_BAR; PG8_SCHED;
            PG8_STAGE(PG8_SB(0, 1), b2 + hB, voffB);
            PG8_WAIT_V(6); PG8_BAR; PG8_MMA(1, 1, At, B1); PG8_BAR;
            PG8_LDB(B0, 1, 0); PG8_SCHED; PG8_LDA(At, 1, 0); PG8_STAGE(PG8_SA(0, 1), a2 + hA, voffA);
            PG8_WAIT_L(8); PG8_BAR; PG8_WAIT_L(0); PG8_MMA(0, 0, At, B0); PG8_BAR; PG8_SCHED;
            PG8_LDB(B1, 1, 1); PG8_STAGE(PG8_SB(1, 0), b3, voffB);
            PG8_BAR; PG8_WAIT_L(0); PG8_MMA(0, 1, At, B1); PG8_BAR;
            PG8_LDA(At, 1, 1); PG8_STAGE(PG8_SA(1, 0), a3, voffA);
            PG8_BAR; PG8_WAIT_L(0); PG8_MMA(1, 0, At, B0); PG8_BAR; PG8_SCHED;
            PG8_STAGE(PG8_SB(1, 1), b3 + hB, voffB);
            PG8_WAIT_V(6); PG8_BAR; PG8_MMA(1, 1, At, B1); PG8_BAR;
                    }
        }
        if constexpr (ALIGN_EPI) { if (wr == 0) PG8_BAR; }
        E(acc, cur, wr, wc, fr, fq);
        if (!has_next) break;
#pragma unroll
        for (int a = 0; a < 2; ++a)
#pragma unroll
            for (int b = 0; b < 2; ++b)
#pragma unroll
                for (int m = 0; m < 4; ++m)
#pragma unroll
                    for (int n = 0; n < 2; ++n) acc[a][b][m][n] = (f32x4){0.f, 0.f, 0.f, 0.f};
        cur = nxt; cA = nA; cB = nB; ++ui;
        if constexpr (ALIGN_EPI) { if (wr == 1) PG8_BAR; }
    }
    PG8_WAIT_V(0);
    if constexpr (!ALIGN_EPI) { if (wr == 0) PG8_BAR; }
    PG8_BAR;
#undef PG8_SA
#undef PG8_SB
#undef PG8_STAGE
#undef PG8_LDA
#undef PG8_LDB
#undef PG8_MMA
#undef PG8_WAIT_V
#undef PG8_WAIT_L
#undef PG8_BAR
#undef PG8_SCHED
#undef PG8_ABASE
#undef PG8_BBASE
}

typedef const f32x4 (&AccRef)[2][2][4][2];

struct EpiF32 {
    static constexpr bool PERM = false;
    float* C; int ldc; size_t zstride;
    __device__ __forceinline__ void operator()(AccRef acc, const Unit& u, int wr, int wc, int fr, int fq) const {
        const int row0 = u.pm * BM + wr * 64 + fr, col0 = u.pn * BM + wc * 32 + 4 * fq;
#pragma unroll
        for (int ai = 0; ai < 2; ++ai)
#pragma unroll
            for (int m = 0; m < 4; ++m) { float* rowp = C + (size_t)u.z * zstride + (size_t)(row0 + ai * HALF + m * 16) * ldc + col0;
#pragma unroll
                for (int bj = 0; bj < 2; ++bj)
#pragma unroll
                    for (int n = 0; n < 2; ++n) *(f32x4*)(rowp + bj * HALF + n * 16) = acc[ai][bj][m][n]; }
    }
};
template <int ACT> struct EpiBf16 {
    static constexpr bool PERM = true;
    bf16_t* O; int ldc; const float* bias; int zcol;
    __device__ __forceinline__ void operator()(AccRef acc, const Unit& u, int wr, int wc, int fr, int fq) const {
        const int row0 = u.pm * BM + wr * 64 + fr; const int ct = u.pn * BM + wc * 32 + 8 * fq; const int col0 = u.z * zcol + ct;
        f32x4 bv[2][2];
#pragma unroll
        for (int bj = 0; bj < 2; ++bj)
#pragma unroll
            for (int n = 0; n < 2; ++n) bv[bj][n] = bias ? *(const f32x4*)(bias + ct + bj * HALF + 4 * n) : (f32x4){0.f, 0.f, 0.f, 0.f};
#pragma unroll
        for (int ai = 0; ai < 2; ++ai)
#pragma unroll
            for (int m = 0; m < 4; ++m) { bf16_t* rowp = O + (size_t)(row0 + ai * HALF + m * 16) * ldc + col0;
#pragma unroll
                for (int bj = 0; bj < 2; ++bj) { f32x4 v0 = acc[ai][bj][m][0] + bv[bj][0], v1 = acc[ai][bj][m][1] + bv[bj][1];
                    if (ACT == 1) {
#pragma unroll
                        for (int j = 0; j < 4; ++j) { v0[j] = sigmoidf_(v0[j]); v1[j] = sigmoidf_(v1[j]); } }
                    if (ACT == 2) {
#pragma unroll
                        for (int j = 0; j < 4; ++j) { const float a = fmaxf(v0[j], 0.f), b = fmaxf(v1[j], 0.f); v0[j] = a * a; v1[j] = b * b; } }
                    u32x4 w; w.x = pkbf(v0[0], v0[1]); w.y = pkbf(v0[2], v0[3]); w.z = pkbf(v1[0], v1[1]); w.w = pkbf(v1[2], v1[3]);
                    *(u32x4*)(rowp + bj * HALF) = w; } }
    }
};
struct EpiUfT {
    static constexpr bool PERM = true;
    bf16_t* X; bf16_t* T;
    __device__ __forceinline__ void operator()(AccRef acc, const Unit& u, int wr, int wc, int fr, int fq) const {
        bf16_t* base; int ldc;
        if (u.pn < 32) { base = X + ((size_t)(u.pn >> 3) * 1024 + u.pm * 256) * 2048 + (u.pn & 7) * 256; ldc = 2048; }
        else { base = T + ((size_t)(u.pn - 32) * 1024 + u.pm * 256) * 256; ldc = 256; }
        const int rr = wr * 64 + fr, cc = wc * 32 + 8 * fq;
#pragma unroll
        for (int ai = 0; ai < 2; ++ai)
#pragma unroll
            for (int m = 0; m < 4; ++m) { bf16_t* rowp = base + (size_t)(rr + ai * HALF + m * 16) * ldc + cc;
#pragma unroll
                for (int bj = 0; bj < 2; ++bj) { const f32x4 v0 = acc[ai][bj][m][0], v1 = acc[ai][bj][m][1];
                    u32x4 w; w.x = pkbf(v0[0], v0[1]); w.y = pkbf(v0[2], v0[3]); w.z = pkbf(v1[0], v1[1]); w.w = pkbf(v1[2], v1[3]);
                    *(u32x4*)(rowp + bj * HALF) = w; } }
    }
};
struct EpiSeqDft {
    static constexpr bool PERM = true;
    bf16_t* G; int nk, L, row_base; unsigned mlim; int nyq;
    __device__ __forceinline__ void operator()(AccRef acc, const Unit& u, int wr, int wc, int fr, int fq) const {
        const int pq = u.pm >= nk ? 1 : 0, kt = u.pm - nk * pq;
        unsigned char* gb = (unsigned char*)(G + (size_t)(row_base + u.z * L) * 2048 + u.pn * 512 + pq * 256);
        const int rr = kt * 256 + wr * 64 + fr, cc = wc * 32 + 8 * fq;
        const unsigned o0 = (unsigned)(rr * 2048 + cc) * 2u, cm = (unsigned)L * 4096u + 4u * (unsigned)cc;
        const unsigned sgn = pq ? 0x80008000u : 0u;
#pragma unroll
        for (int ai = 0; ai < 2; ++ai)
#pragma unroll
            for (int m = 0; m < 4; ++m) { const unsigned o = o0 + (unsigned)((ai * HALF + m * 16) * 4096); const bool mir = (unsigned)(rr + ai * HALF + m * 16 - 1) < mlim;
#pragma unroll
                for (int bj = 0; bj < 2; ++bj) { const f32x4 v0 = acc[ai][bj][m][0], v1 = acc[ai][bj][m][1];
                    u32x4 w; w.x = pkbf(v0[0], v0[1]); w.y = pkbf(v0[2], v0[3]); w.z = pkbf(v1[0], v1[1]); w.w = pkbf(v1[2], v1[3]);
                    if (ai == 0 && m == 0) {
                        const bool sp = nyq && pq && rr == 0;
                        if (sp) { *(u32x4*)(gb + o + bj * HALF * 2 + (1024 * 4096 - 512)) = w; *(u32x4*)(gb + o + bj * HALF * 2 + 1024 * 4096) = (u32x4){0u, 0u, 0u, 0u}; w = (u32x4){0u, 0u, 0u, 0u}; }
                    }
                    *(u32x4*)(gb + o + bj * HALF * 2) = w;
                    if (mir) { u32x4 wm; wm.x = w.x ^ sgn; wm.y = w.y ^ sgn; wm.z = w.z ^ sgn; wm.w = w.w ^ sgn; *(u32x4*)(gb + (cm - o) + bj * HALF * 2) = wm; } } }
    }
};
struct EpiQRope {
    static constexpr bool PERM = false;
    bf16_t* Q; const float* rope;
    __device__ __forceinline__ void operator()(AccRef acc, const Unit& u, int wr, int wc, int fr, int fq) const {
        const int row0 = u.pm * BM + wr * 64 + fr, col0 = u.pn * BM + wc * 32 + 4 * fq;
        const bool xrows = (u.pm * BM) < NX;
#pragma unroll
        for (int bj = 0; bj < 2; ++bj) {
            const int grp = 8 * u.pn + 4 * bj + wc, gm = grp % 6; const bool is_rope = xrows && (gm >= 4); const int axis = gm - 4;
            f32x4 cs0[2][4], cs1[2][4];
            if (is_rope) {
#pragma unroll
                for (int ai = 0; ai < 2; ++ai)
#pragma unroll
                    for (int m = 0; m < 4; ++m) { const int n = (row0 + ai * HALF + m * 16) & (SEQ - 1); const int pos = axis ? (n & 63) : (n >> 6);
                        const float* rp = rope + (pos * 16 + 4 * fq) * 2; cs0[ai][m] = *(const f32x4*)rp; cs1[ai][m] = *(const f32x4*)(rp + 4); }
                asm volatile("" ::: "memory");
            }
#pragma unroll
            for (int ai = 0; ai < 2; ++ai)
#pragma unroll
                for (int m = 0; m < 4; ++m) {
                    const int row = row0 + ai * HALF + m * 16;
                    f32x4 x1 = acc[ai][bj][m][0] * QSCALE, x2 = acc[ai][bj][m][1] * QSCALE;
                    if (is_rope) {
                        const f32x4 c = (f32x4){cs0[ai][m][0], cs0[ai][m][2], cs1[ai][m][0], cs1[ai][m][2]}, sn = (f32x4){cs0[ai][m][1], cs0[ai][m][3], cs1[ai][m][1], cs1[ai][m][3]};
                        const f32x4 o1 = x1 * c - x2 * sn, o2 = x2 * c + x1 * sn; x1 = o1; x2 = o2;
                    }
                    bf16_t* p = Q + (size_t)row * 3072 + col0 + bj * HALF;
                    u32x2 w0, w1; w0.x = pkbf(x1[0], x1[1]); w0.y = pkbf(x1[2], x1[3]); w1.x = pkbf(x2[0], x2[1]); w1.y = pkbf(x2[2], x2[3]);
                    *(u32x2*)p = w0; *(u32x2*)(p + 16) = w1;
                }
        }
    }
};
__device__ __forceinline__ size_t gate_tile_off(int pm, int pncol  ) { return ((size_t)pm * 48 + pncol) * 65536; }
struct EpiGatesImg {
    static constexpr bool PERM = true;
    bf16_t* G; const float* bias;
    __device__ __forceinline__ void operator()(AccRef acc, const Unit& u, int wr, int wc, int fr, int fq) const {
        const int ct = u.pn * BM + wc * 32 + 8 * fq;
        const int wl = ((wr * 4 + wc) * 64 + fq * 16 + fr) * 8;
        bf16_t* tb = G + gate_tile_off(u.pm, u.pn) + wl;
        f32x4 bv[2][2];
#pragma unroll
        for (int bj = 0; bj < 2; ++bj)
#pragma unroll
            for (int n = 0; n < 2; ++n) bv[bj][n] = *(const f32x4*)(bias + ct + bj * HALF + 4 * n);
#pragma unroll
        for (int ai = 0; ai < 2; ++ai)
#pragma unroll
            for (int m = 0; m < 4; ++m)
#pragma unroll
                for (int bj = 0; bj < 2; ++bj) { f32x4 v0 = acc[ai][bj][m][0] + bv[bj][0], v1 = acc[ai][bj][m][1] + bv[bj][1];
#pragma unroll
                    for (int j = 0; j < 4; ++j) { v0[j] = sigmoidf_(v0[j]); v1[j] = sigmoidf_(v1[j]); }
                    u32x4 w; w.x = pkbf(v0[0], v0[1]); w.y = pkbf(v0[2], v0[3]); w.z = pkbf(v1[0], v1[1]); w.w = pkbf(v1[2], v1[3]);
                    *(u32x4*)(tb + (size_t)(((ai * 4 + m) * 2 + bj) * 4096)) = w; }
    }
};
template <int MODE> struct EpiGate {
    static constexpr bool PERM = true;
    bf16_t* MB; const bf16_t* gates; bf16_t* OUT;
    __device__ __forceinline__ void operator()(AccRef acc, const Unit& u, int wr, int wc, int fr, int fq) const {
        const int row0 = u.pm * BM + wr * 64 + fr, col0 = u.pn * BM + wc * 32 + 8 * fq;
        const int gtile = (MODE == 2) ? 32 : (u.z == 0 ? 16 : 0);
        const int wl = ((wr * 4 + wc) * 64 + fq * 16 + fr) * 8;
        const bf16_t* gt = gates + gate_tile_off(u.pm, gtile + u.pn) + wl;
        const size_t mtile = ((size_t)u.pm * 16 + u.pn) * 65536 + wl;
        bf16_t* mz = MB + (size_t)u.z * NR * 4096 + mtile;
        const bf16_t* m0 = MB + mtile; const bf16_t* m1 = MB + (size_t)NR * 4096 + mtile;
#pragma unroll
        for (int ab = 0; ab < 4; ++ab) { const int ai = ab >> 1, mb = (ab & 1) * 2;
            u32x4 gw[2][2], ca[2][2], cf[2][2];
#pragma unroll
            for (int mi = 0; mi < 2; ++mi)
#pragma unroll
                for (int bj = 0; bj < 2; ++bj) { const size_t po = (size_t)(((ai * 4 + mb + mi) * 2 + bj) * 4096);
                    gw[mi][bj] = *(const u32x4*)(gt + po);
                    if (MODE == 2) { ca[mi][bj] = *(const u32x4*)(m0 + po); cf[mi][bj] = *(const u32x4*)(m1 + po); } }
            asm volatile("" ::: "memory");
#pragma unroll
            for (int mi = 0; mi < 2; ++mi) { const int m = mb + mi; const size_t row = (size_t)(row0 + ai * HALF + m * 16);
#pragma unroll
                for (int bj = 0; bj < 2; ++bj) { const int col = col0 + bj * HALF; const u32x4 g = gw[mi][bj];
                    const f32x4 g0 = (f32x4){bflo(g.x), bfhi(g.x), bflo(g.y), bfhi(g.y)}, g1 = (f32x4){bflo(g.z), bfhi(g.z), bflo(g.w), bfhi(g.w)};
                    f32x4 v0 = acc[ai][bj][m][0] * g0, v1 = acc[ai][bj][m][1] * g1;
                    if (MODE == 2) { const u32x4 a_ = ca[mi][bj], f_ = cf[mi][bj];
                        v0 += (f32x4){bflo(a_.x), bfhi(a_.x), bflo(a_.y), bfhi(a_.y)} + (f32x4){bflo(f_.x), bfhi(f_.x), bflo(f_.y), bfhi(f_.y)};
                        v1 += (f32x4){bflo(a_.z), bfhi(a_.z), bflo(a_.w), bfhi(a_.w)} + (f32x4){bflo(f_.z), bfhi(f_.z), bflo(f_.w), bfhi(f_.w)}; }
                    u32x4 w; w.x = pkbf(v0[0], v0[1]); w.y = pkbf(v0[2], v0[3]); w.z = pkbf(v1[0], v1[1]); w.w = pkbf(v1[2], v1[3]);
                    if (MODE == 2) *(u32x4*)(OUT + row * 4096 + col) = w;
                    else *(u32x4*)(mz + (size_t)(((ai * 4 + m) * 2 + bj) * 4096)) = w; } }
        }
    }
};
}

struct Args { const float* in[29]; float* out; unsigned char* ws; int ph_lo, ph_hi; };
typedef const __attribute__((address_space(4))) Args* ArgP;
__device__ __forceinline__ ArgP get_args() { ArgP p = (ArgP)__builtin_amdgcn_kernarg_segment_ptr(); asm volatile("" : "+s"(p)); return p; }
enum { I_X = 0, I_C, I_CTX, I_CCTX, I_GMIXPRE, I_GMIXPOST, I_GMLPPRE, I_GMLPPOST, I_WMODA, I_WMODB, I_BMOD, I_WIN, I_CONVW, I_CONVB, I_CLNG, I_CLNB,
       I_QNG, I_WUQ, I_KVNG, I_WUKV, I_WPF, I_WPC, I_WPM, I_WGA, I_WGB, I_BGATE, I_WOUT, I_WFF1, I_WFF2 };

template <bool KVPERM>
__device__ __forceinline__ void transpose_item(const float* W, int N, bf16_t* WT, int ldo, int row_off, LAS float* scr, int item, int lane) {
    const int nblk = N / 32, kb = item / nblk, nb = item % nblk, k0 = 64 * kb, n0 = 32 * nb;
    float wv[32];
#pragma unroll
    for (int i = 0; i < 32; ++i) { const int kk = 2 * i + (lane >> 5); wv[i] = __builtin_nontemporal_load(W + (size_t)(k0 + kk) * N + n0 + (lane & 31)); }
    asm volatile("" ::: "memory");
#pragma unroll
    for (int i = 0; i < 32; ++i) { const int kk = 2 * i + (lane >> 5); scr[kk * 33 + (lane & 31)] = wv[i]; }
    LDS_WAIT();
    const int c = lane & 7;
#pragma unroll
    for (int j = 0; j < 4; ++j) { const int n = (lane >> 3) + 8 * j; const LAS float* s = scr + (8 * c) * 33 + n;
        u32x4 o; o.x = pk2(s[0 * 33], s[1 * 33]); o.y = pk2(s[2 * 33], s[3 * 33]); o.z = pk2(s[4 * 33], s[5 * 33]); o.w = pk2(s[6 * 33], s[7 * 33]);
        int orow = row_off + n0 + n; if (KVPERM) { const int nn = n0 + n; orow = ((nn & 128) ? 2048 : 0) + (nn >> 8) * 128 + (nn & 127); }
        *(u32x4*)(WT + (size_t)orow * ldo + k0 + 8 * c) = o; }
    LDS_WAIT();
}
template <bool KVPERM = false>
__device__ __forceinline__ void transpose_matrix(const float* W, int K, int N, bf16_t* WT, int ldo, int row_off, LAS float* scr, int gw, int NGW, int lane, int first_item = 0) {
    const int items = (K / 64) * (N / 32);
    for (int it = first_item + gw; it < items; it += NGW) transpose_item<KVPERM>(W, N, WT, ldo, row_off, scr, it, lane);
}

constexpr int DEF_PER_WAVE = 32, DEF_WAVES = 192 * 8, DEF_ITEMS = DEF_PER_WAVE * DEF_WAVES;
constexpr int W1_ITEMS = (4096 / 64) * (DFF / 32), DEF_W1 = DEF_ITEMS < W1_ITEMS ? DEF_ITEMS : W1_ITEMS, DEF_W2 = DEF_ITEMS - DEF_W1;
__device__ __forceinline__ void phase_pro0(ArgP a, LAS unsigned char* lds, int tid, int lane, int wave) {
    unsigned char* ws = a->ws;
    const int G = gridDim.x, gw = blockIdx.x * 8 + wave, NGW = G * 8;
    if (blockIdx.x < 32) {
        LAS float* sc = (LAS float*)lds;
        LAS float* red = sc + 5 * 4096;
        for (int i = tid; i < 5 * 4096; i += 512) { const int r = i >> 12, k = i & 4095; const float v = (r < 4) ? a->in[I_C][r * 4096 + k] : a->in[I_CCTX][k]; sc[i] = v * sigmoidf_(v); }
        __syncthreads();
        const int l = blockIdx.x >> 3, jc = blockIdx.x & 7, kg = tid >> 5, j = tid & 31;
        const float* wa = a->in[I_WMODA] + (size_t)l * 4096 * 256 + jc * 32 + j;
        float acc[5] = {0.f, 0.f, 0.f, 0.f, 0.f};
        for (int k = kg; k < 4096; k += 16) { const float w = wa[(size_t)k * 256];
#pragma unroll
            for (int r = 0; r < 5; ++r) acc[r] += sc[r * 4096 + k] * w; }
#pragma unroll
        for (int r = 0; r < 5; ++r) red[(kg * 5 + r) * 32 + j] = acc[r];
        __syncthreads();
        if (tid < 160) { const int r = tid >> 5, jj = tid & 31; float s = 0.f; for (int q = 0; q < 16; ++q) s += red[(q * 5 + r) * 32 + jj];
            ((float*)(ws + WS_A1))[(l * 5 + r) * 256 + jc * 32 + jj] = s; }
        __syncthreads();
    }
    {
        bf16_t* dx = (bf16_t*)(ws + WS_DFTX);
        const float nx = 0.022097086912079608f;
        for (int i = blockIdx.x * 512 + tid; i < 2048 * 2048 / 8; i += G * 512) { const int r = i / 256, n0 = (i % 256) * 8; const int pq = r > 1024 ? 1 : 0, k = r - 1024 * pq;
            unsigned w[4];
#pragma unroll
            for (int e = 0; e < 8; e += 2) { const int p0 = (k * (n0 + e)) & 2047, p1 = (k * (n0 + e + 1)) & 2047;
                const float a0 = (float)p0 * (1.0f / 2048.0f), a1 = (float)p1 * (1.0f / 2048.0f);
                const float t0 = pq ? __builtin_amdgcn_sinf(a0) : __builtin_amdgcn_cosf(a0), t1 = pq ? __builtin_amdgcn_sinf(a1) : __builtin_amdgcn_cosf(a1);
                w[e / 2] = pk2(t0 * nx, t1 * nx); }
            *(u32x4*)(dx + (size_t)r * 2048 + n0) = (u32x4){w[0], w[1], w[2], w[3]}; }
        bf16_t* dt = (bf16_t*)(ws + WS_DFTT);
        for (int i = blockIdx.x * 512 + tid; i < 512 * 256; i += G * 512) { const int r = i / 256, n = i % 256, k = r & 255, pq = r >> 8; float s, c;
            sincospif((float)((k * n) & 255) * (1.0f / 128.0f), &s, &c); dt[i] = (bf16_t)f2bf((pq ? s : c) * 0.0625f); }
        bf16_t* dc = (bf16_t*)(ws + WS_DFTC);
        for (int i = blockIdx.x * 512 + tid; i < 256 * 512; i += G * 512) { const int k2 = i / 512, q = i % 512, pq = q >> 8, cc = q & 255; float s, c;
            sincospif((float)((k2 * cc) & 255) * (1.0f / 128.0f), &s, &c); dc[i] = (bf16_t)f2bf((pq ? -s : c) * 0.0625f); }
        float* rt = (float*)(ws + WS_ROPE);
        for (int i = blockIdx.x * 512 + tid; i < 64 * 16; i += G * 512) { const int pos = i / 16, f = i % 16; const float inv = powf(10000.0f, -(float)f / 16.0f); const float ang = (float)pos * inv;
            rt[2 * i] = cosf(ang); rt[2 * i + 1] = sinf(ang); }
    }
    LAS float* scr = (LAS float*)(lds + wave * 16384);
    for (int l = 0; l < DEPTH; ++l) {
        unsigned char* wl = ws + WS_W + (size_t)l * LW;
        transpose_matrix(a->in[I_WIN] + (size_t)l * 4096 * DIN, 4096, DIN, (bf16_t*)(wl + OW_IN), 4096, 0, scr, gw, NGW, lane);
        transpose_matrix(a->in[I_WGA] + (size_t)l * 4096 * 512, 4096, 512, (bf16_t*)(wl + OW_IN), 4096, U_GA, scr, gw, NGW, lane);
        { u32x4* z = (u32x4*)((bf16_t*)(wl + OW_IN) + (size_t)U_END * 4096); for (int i = blockIdx.x * 512 + tid; i < (NU - U_END) * 4096 / 8; i += G * 512) z[i] = (u32x4){0u, 0u, 0u, 0u}; }
        transpose_matrix(a->in[I_WUQ] + (size_t)l * 1024 * 3072, 1024, 3072, (bf16_t*)(wl + OW_UQ), 1024, 0, scr, gw, NGW, lane);
        transpose_matrix<true>(a->in[I_WUKV] + (size_t)l * 512 * 4096, 512, 4096, (bf16_t*)(wl + OW_UKV), 512, 0, scr, gw, NGW, lane);
        transpose_matrix(a->in[I_WPF] + (size_t)l * 1024 * 4096, 1024, 4096, (bf16_t*)(wl + OW_PF), 1024, 0, scr, gw, NGW, lane);
        transpose_matrix(a->in[I_WPC] + (size_t)l * 1024 * 4096, 1024, 4096, (bf16_t*)(wl + OW_PC), 1024, 0, scr, gw, NGW, lane);
        transpose_matrix(a->in[I_WPM] + (size_t)l * 2048 * 4096, 2048, 4096, (bf16_t*)(wl + OW_PM), 2048, 0, scr, gw, NGW, lane);
        transpose_matrix(a->in[I_WGB] + (size_t)l * 512 * 12288, 512, 12288, (bf16_t*)(wl + OW_GB), 512, 0, scr, gw, NGW, lane);
        transpose_matrix(a->in[I_WOUT] + (size_t)l * 4096 * 4096, 4096, 4096, (bf16_t*)(wl + OW_OUT), 4096, 0, scr, gw, NGW, lane);
        transpose_matrix(a->in[I_WFF1] + (size_t)l * 4096 * DFF, 4096, DFF, (bf16_t*)(wl + OW_1), 4096, 0, scr, gw, NGW, lane, (l > 0 && gridDim.x == 256) ? DEF_W1 : 0);
        transpose_matrix(a->in[I_WFF2] + (size_t)l * DFF * 4096, DFF, 4096, (bf16_t*)(wl + OW_2), DFF, 0, scr, gw, NGW, lane, (l > 0 && gridDim.x == 256) ? DEF_W2 : 0);
    }
}
__device__ __forceinline__ void phase_pro1(ArgP a, LAS unsigned char* lds, int tid) {
    LAS float* a1s = (LAS float*)lds;
    for (int t0 = blockIdx.x * 512; t0 < DEPTH * 24576; t0 += gridDim.x * 512) {
        const int l = t0 / 24576;
        __syncthreads();
        for (int i = tid; i < 5 * 256; i += 512) a1s[i] = ((const float*)(a->ws + WS_A1))[l * 1280 + i];
        __syncthreads();
        const int j = (t0 + tid) % 24576;
        const float* wb = a->in[I_WMODB] + (size_t)l * 256 * 24576 + j;
        const float b = a->in[I_BMOD][l * 24576 + j];
        float acc[5] = {b, b, b, b, b};
        for (int k = 0; k < 256; ++k) { const float w = wb[(size_t)k * 24576];
#pragma unroll
            for (int r = 0; r < 5; ++r) acc[r] += a1s[r * 256 + k] * w; }
#pragma unroll
        for (int r = 0; r < 5; ++r) ((float*)(a->ws + WS_MODS))[((size_t)l * 5 + r) * 24576 + j] = acc[r];
    }
}
#define RCOL(j) (8 * (lane + 64 * ((j) >> 1)) + 4 * ((j) & 1))
__device__ __forceinline__ void modulate_store(const f32x4 (&v)[16], const float* g, const float* shift, const float* scale, bf16_t* orow, int lane) {
    float ss = 0.f;
#pragma unroll
    for (int j = 0; j < 16; ++j) ss += (v[j][0] * v[j][0] + v[j][1] * v[j][1]) + (v[j][2] * v[j][2] + v[j][3] * v[j][3]);
    const float r = rsqrtf(wave_sum(ss) * (1.0f / 4096.0f) + EPS);
#pragma unroll
    for (int j2 = 0; j2 < 8; ++j2) { u32x4 w;
#pragma unroll
        for (int e = 0; e < 2; ++e) { const int j = 2 * j2 + e, c = RCOL(j);
            const f32x4 gv = *(const f32x4*)(g + c), sh = *(const f32x4*)(shift + c), sc = *(const f32x4*)(scale + c);
            const f32x4 o = (v[j] * r) * gv * (sc + 1.0f) + sh;
            if (e == 0) { w.x = pkbf(o[0], o[1]); w.y = pkbf(o[2], o[3]); } else { w.z = pkbf(o[0], o[1]); w.w = pkbf(o[2], o[3]); } }
        *(u32x4*)(orow + RCOL(2 * j2)) = w; }
}
__device__ __forceinline__ const float* mods_row(ArgP a, int l, int row) { const int mb = row < NX ? (row >> 11) : 4; return (const float*)(a->ws + WS_MODS) + ((size_t)l * 5 + mb) * 24576; }
__device__ __forceinline__ void phase_pro2(ArgP a, int lane, int wave) {
    const int gw = blockIdx.x * 8 + wave, NGW = gridDim.x * 8;
    for (int row = gw; row < NR; row += NGW) {
        const float* src = row < NX ? a->in[I_X] + (size_t)row * 4096 : a->in[I_CTX] + (size_t)(row - NX) * 4096;
        f32x4 v[16];
#pragma unroll
        for (int j = 0; j < 16; ++j) v[j] = *(const f32x4*)(src + RCOL(j));
        const float* md = mods_row(a, 0, row);
        modulate_store(v, a->in[I_GMIXPRE], md, md + 4096, (bf16_t*)(a->ws + WS_H) + (size_t)row * 4096, lane);
    }
}
__device__ __forceinline__ void residual_row(ArgP a, int l, int which, int row, bool final_out, const LAS float* vg, int lane) {
    const bool from_input = (l == 0 && which == 0);
    const float* src = row < NX ? a->in[I_X] + (size_t)row * 4096 : a->in[I_CTX] + (size_t)(row - NX) * 4096;
    bf16_t* resrow = (bf16_t*)(a->ws + WS_RES) + (size_t)row * 4096;
    f32x4 v[16]; float ss = 0.f;
    if (row < NX) {
        const bf16_t* yrow = (const bf16_t*)(a->ws + WS_Y) + (size_t)row * 4096;
#pragma unroll
        for (int j2 = 0; j2 < 8; ++j2) { const u32x4 w = *(const u32x4*)(yrow + RCOL(2 * j2));
            v[2 * j2] = (f32x4){bflo(w.x), bfhi(w.x), bflo(w.y), bfhi(w.y)}; v[2 * j2 + 1] = (f32x4){bflo(w.z), bfhi(w.z), bflo(w.w), bfhi(w.w)}; }
    } else {
        const float* ys = (const float*)(a->ws + WS_YS) + (size_t)(row - NX) * 4096;
#pragma unroll
        for (int j = 0; j < 16; ++j) { const int c = RCOL(j);
            v[j] = (*(const f32x4*)(ys + c) + *(const f32x4*)(ys + (size_t)NT * 4096 + c)) + (*(const f32x4*)(ys + (size_t)2 * NT * 4096 + c) + *(const f32x4*)(ys + (size_t)3 * NT * 4096 + c));
            if ((j & 3) == 3) asm volatile("" ::: "memory"); }
    }
#pragma unroll
    for (int j = 0; j < 16; ++j) ss += (v[j][0] * v[j][0] + v[j][1] * v[j][1]) + (v[j][2] * v[j][2] + v[j][3] * v[j][3]);
    const float r = rsqrtf(wave_sum(ss) * (1.0f / 4096.0f) + EPS);
    if (from_input) {
#pragma unroll
        for (int j = 0; j < 16; ++j) { const int c = RCOL(j);
            v[j] = *(const f32x4*)(src + c) + *(const LAS f32x4*)(vg + 4096 + c) * ((v[j] * r) * *(const LAS f32x4*)(vg + c));
            if ((j & 3) == 3) asm volatile("" ::: "memory"); }
    } else {
#pragma unroll
        for (int j2 = 0; j2 < 8; ++j2) { const u32x4 w = *(const u32x4*)(resrow + RCOL(2 * j2));
            const f32x4 x0 = (f32x4){bflo(w.x), bfhi(w.x), bflo(w.y), bfhi(w.y)}, x1 = (f32x4){bflo(w.z), bfhi(w.z), bflo(w.w), bfhi(w.w)};
            const int c0 = RCOL(2 * j2), c1 = RCOL(2 * j2 + 1);
            v[2 * j2] = x0 + *(const LAS f32x4*)(vg + 4096 + c0) * ((v[2 * j2] * r) * *(const LAS f32x4*)(vg + c0));
            v[2 * j2 + 1] = x1 + *(const LAS f32x4*)(vg + 4096 + c1) * ((v[2 * j2 + 1] * r) * *(const LAS f32x4*)(vg + c1));
            if (j2 & 1) asm volatile("" ::: "memory"); }
    }
    if (final_out) {
#pragma unroll
        for (int j = 0; j < 16; ++j) *(f32x4*)(a->out + (size_t)row * 4096 + RCOL(j)) = v[j];
    } else {
#pragma unroll
        for (int j2 = 0; j2 < 8; ++j2) { u32x4 w; w.x = pkbf(v[2 * j2][0], v[2 * j2][1]); w.y = pkbf(v[2 * j2][2], v[2 * j2][3]); w.z = pkbf(v[2 * j2 + 1][0], v[2 * j2 + 1][1]); w.w = pkbf(v[2 * j2 + 1][2], v[2 * j2 + 1][3]);
            *(u32x4*)(resrow + RCOL(2 * j2)) = w; }
        float s2 = 0.f;
#pragma unroll
        for (int j = 0; j < 16; ++j) s2 += (v[j][0] * v[j][0] + v[j][1] * v[j][1]) + (v[j][2] * v[j][2] + v[j][3] * v[j][3]);
        const float r2 = rsqrtf(wave_sum(s2) * (1.0f / 4096.0f) + EPS);
        bf16_t* orow = (bf16_t*)(a->ws + WS_H) + (size_t)row * 4096;
#pragma unroll
        for (int j2 = 0; j2 < 8; ++j2) { u32x4 w;
#pragma unroll
            for (int e = 0; e < 2; ++e) { const int j = 2 * j2 + e, c = RCOL(j);
                const f32x4 o = (v[j] * r2) * *(const LAS f32x4*)(vg + 2 * 4096 + c) * (*(const LAS f32x4*)(vg + 4 * 4096 + c) + 1.0f) + *(const LAS f32x4*)(vg + 3 * 4096 + c);
                if (e == 0) { w.x = pkbf(o[0], o[1]); w.y = pkbf(o[2], o[3]); } else { w.z = pkbf(o[0], o[1]); w.w = pkbf(o[2], o[3]); } }
            *(u32x4*)(orow + RCOL(2 * j2)) = w;
            if (j2 & 1) asm volatile("" ::: "memory"); }
    }
}
__device__ __forceinline__ void residual_fill(ArgP a, int l, int which, int mb, bool final_out, LAS float* vg, int tid) {
    const float* gpost = a->in[which == 0 ? I_GMIXPOST : I_GMLPPOST] + l * 4096;
    const float* md = (const float*)(a->ws + WS_MODS) + ((size_t)l * 5 + mb) * 24576;
    const float* gate = md + (which == 0 ? 2 : 5) * 4096;
    const float* g2; const float* sh; const float* sc;
    if (which == 0) { g2 = a->in[I_GMLPPRE] + l * 4096; sh = md + 3 * 4096; sc = md + 4 * 4096; }
    else { const int l2 = final_out ? l : l + 1; const float* md2 = (const float*)(a->ws + WS_MODS) + ((size_t)l2 * 5 + mb) * 24576; g2 = a->in[I_GMIXPRE] + l2 * 4096; sh = md2; sc = md2 + 4096; }
#pragma unroll
    for (int k = 0; k < 2; ++k) { const int c = 4 * (tid + 512 * k);
        *(LAS f32x4*)(vg + c) = *(const f32x4*)(gpost + c); *(LAS f32x4*)(vg + 4096 + c) = *(const f32x4*)(gate + c);
        if (!final_out) { *(LAS f32x4*)(vg + 2 * 4096 + c) = *(const f32x4*)(g2 + c); *(LAS f32x4*)(vg + 3 * 4096 + c) = *(const f32x4*)(sh + c); *(LAS f32x4*)(vg + 4 * 4096 + c) = *(const f32x4*)(sc + c); } }
}
__device__ __forceinline__ void phase_residual(ArgP a, int l, int which, LAS unsigned char* lds, int tid, int lane, int wave) {
    const int G = gridDim.x;
    const bool lastl = (l == DEPTH - 1); const bool final_out = lastl && which == 1;
    LAS float* vg = (LAS float*)lds;
    const int bpb = G / NB;
    const int rpb = SEQ / bpb;
    {
        const int mb = blockIdx.x / bpb, r0 = mb * SEQ + (blockIdx.x % bpb) * rpb;
        residual_fill(a, l, which, mb, final_out, vg, tid);
        __syncthreads();
#pragma unroll 1
        for (int i = wave; i < rpb; i += 8) residual_row(a, l, which, r0 + i, final_out, vg, lane);
    }
    if (!lastl) {
        __syncthreads();
        residual_fill(a, l, which, 4, false, vg, tid);
        __syncthreads();
        if (wave < 4)
#pragma unroll 1
        for (int row = NX + blockIdx.x * 4 + wave; row < NR; row += G * 4) residual_row(a, l, which, row, false, vg, lane);
    }
    __syncthreads();
}
__device__ __forceinline__ void phase_postu(ArgP a, int l, LAS unsigned char* lds, int tid, int lane, int wave) {
    const int G = gridDim.x, gw = blockIdx.x * 8 + wave, NGW = G * 8;
    const bf16_t* U = (const bf16_t*)(a->ws + WS_U);
    {
        LAS float* red = (LAS float*)lds;
        const int c = 2 * tid;
        const float* cw = a->in[I_CONVW] + (size_t)l * 31 * 1024 + c;
        f32x2 wj[31];
#pragma unroll
        for (int j = 0; j < 31; ++j) wj[j] = *(const f32x2*)(cw + j * 1024);
        const f32x2 cb = *(const f32x2*)(a->in[I_CONVB] + l * 1024 + c), lg = *(const f32x2*)(a->in[I_CLNG] + l * 1024 + c), lb = *(const f32x2*)(a->in[I_CLNB] + l * 1024 + c);
        const int nconv = (l == DEPTH - 1 ? NX : NR) / 16;
        for (int it = blockIdx.x; it < nconv; it += G) {
            const int row0 = it * 16; int s0, L;
            if (row0 < NX) { s0 = row0 & ~2047; L = 2048; } else { s0 = NX + ((row0 - NX) & ~255); L = 256; }
            const int n0 = row0 - s0;
            f32x2 acc[16];
#pragma unroll
            for (int o = 0; o < 16; ++o) acc[o] = (f32x2){0.f, 0.f};
#pragma unroll
            for (int hf = 0; hf < 2; ++hf) {
                unsigned aw[23], gwd[23];
#pragma unroll
                for (int ii = 0; ii < 23; ++ii) { const int nn = n0 + hf * 23 + ii - 15; const int nc = nn < 0 ? 0 : (nn >= L ? L - 1 : nn);
                    const bf16_t* up = U + (size_t)(s0 + nc) * NU + c; aw[ii] = *(const unsigned*)(up + U_CA); gwd[ii] = *(const unsigned*)(up + U_CG); }
                asm volatile("" ::: "memory");
#pragma unroll
                for (int ii = 0; ii < 23; ++ii) { const int i = hf * 23 + ii; const int nn = n0 + i - 15; const float msk = (nn >= 0 && nn < L) ? 1.0f : 0.0f;
                    const f32x2 v = (f32x2){bflo(aw[ii]) * sigmoidf_(bflo(gwd[ii])) * msk, bfhi(aw[ii]) * sigmoidf_(bfhi(gwd[ii])) * msk};
#pragma unroll
                    for (int o = 0; o < 16; ++o) { const int j = i - o; if (j >= 0 && j < 31) acc[o] += v * wj[j]; } }
            }
            float st[32];
#pragma unroll
            for (int o = 0; o < 16; ++o) { acc[o] += cb; st[o] = wave_sum(acc[o][0] + acc[o][1]); st[16 + o] = wave_sum(acc[o][0] * acc[o][0] + acc[o][1] * acc[o][1]); }
            __syncthreads();
            if (lane == 0) {
#pragma unroll
                for (int k = 0; k < 32; ++k) red[wave * 32 + k] = st[k]; }
            __syncthreads();
            if (tid < 32) { float t = 0.f;
#pragma unroll
                for (int w = 0; w < 8; ++w) t += red[w * 32 + tid];
                red[256 + tid] = t; }
            __syncthreads();
#pragma unroll
            for (int o = 0; o < 16; ++o) { const float mean = red[256 + o] * (1.0f / 1024.0f); const float var = fmaxf(red[256 + 16 + o] * (1.0f / 1024.0f) - mean * mean, 0.f);
                const float rstd = rsqrtf(var + EPS);
                const float o0 = (acc[o][0] - mean) * rstd * lg[0] + lb[0], o1 = (acc[o][1] - mean) * rstd * lg[1] + lb[1];
                *(unsigned*)((bf16_t*)(a->ws + WS_CACT) + (size_t)(row0 + o) * 1024 + c) = pkbf(o0 * sigmoidf_(o0), o1 * sigmoidf_(o1)); }
        }
    }
    {
        const float* qg = a->in[I_QNG] + l * 1024; const float* kg = a->in[I_KVNG] + l * 512; const float* rope = (const float*)(a->ws + WS_ROPE);
        f32x4 qgv[4], kgv[2];
#pragma unroll
        for (int j = 0; j < 2; ++j) { qgv[2 * j] = *(const f32x4*)(qg + 8 * (lane + 64 * j)); qgv[2 * j + 1] = *(const f32x4*)(qg + 8 * (lane + 64 * j) + 4); }
        kgv[0] = *(const f32x4*)(kg + 8 * lane); kgv[1] = *(const f32x4*)(kg + 8 * lane + 4);
        const bool skew = (G == 256) && (l != DEPTH - 1);
        const int gw2 = skew ? (blockIdx.x < 64 ? NR : (int)(blockIdx.x - 64) * 8 + wave) : gw, NGW2 = skew ? 192 * 8 : NGW;
#pragma unroll 1
        for (int row = gw2; row < NR; row += NGW2) {
            const bf16_t* up = U + (size_t)row * NU;
            const u32x4 wq0 = *(const u32x4*)(up + U_Q + 8 * lane), wq1 = *(const u32x4*)(up + U_Q + 8 * (lane + 64));
            const u32x4 wk = *(const u32x4*)(up + U_KV + 8 * lane);
            const float val = bf2f(up[U_KR + lane]), par = bf2f(up[U_KR + (lane ^ 16)]);
            const int n = row & 2047, axis = lane >> 5, half = (lane >> 4) & 1, f = lane & 15; const int pos = axis ? (n & 63) : (n >> 6);
            const float cs = rope[(pos * 16 + f) * 2], sn = rope[(pos * 16 + f) * 2 + 1];
            asm volatile("" ::: "memory");
            {
                float v[16];
                v[0] = bflo(wq0.x); v[1] = bfhi(wq0.x); v[2] = bflo(wq0.y); v[3] = bfhi(wq0.y); v[4] = bflo(wq0.z); v[5] = bfhi(wq0.z); v[6] = bflo(wq0.w); v[7] = bfhi(wq0.w);
                v[8] = bflo(wq1.x); v[9] = bfhi(wq1.x); v[10] = bflo(wq1.y); v[11] = bfhi(wq1.y); v[12] = bflo(wq1.z); v[13] = bfhi(wq1.z); v[14] = bflo(wq1.w); v[15] = bfhi(wq1.w);
                float ss = 0.f;
#pragma unroll
                for (int e = 0; e < 16; ++e) ss += v[e] * v[e];
                const float r = rsqrtf(wave_sum(ss) * (1.0f / 1024.0f) + EPS);
#pragma unroll
                for (int j = 0; j < 2; ++j) { const int c0 = 8 * (lane + 64 * j); const f32x4 g0 = qgv[2 * j], g1 = qgv[2 * j + 1];
                    u32x4 o; o.x = pkbf(v[8 * j] * r * g0[0], v[8 * j + 1] * r * g0[1]); o.y = pkbf(v[8 * j + 2] * r * g0[2], v[8 * j + 3] * r * g0[3]);
                    o.z = pkbf(v[8 * j + 4] * r * g1[0], v[8 * j + 5] * r * g1[1]); o.w = pkbf(v[8 * j + 6] * r * g1[2], v[8 * j + 7] * r * g1[3]);
                    *(u32x4*)((bf16_t*)(a->ws + WS_QIN) + (size_t)row * 1024 + c0) = o; }
            }
            {
                float v[8];
                v[0] = bflo(wk.x); v[1] = bfhi(wk.x); v[2] = bflo(wk.y); v[3] = bfhi(wk.y); v[4] = bflo(wk.z); v[5] = bfhi(wk.z); v[6] = bflo(wk.w); v[7] = bfhi(wk.w);
                float ss = 0.f;
#pragma unroll
                for (int e = 0; e < 8; ++e) ss += v[e] * v[e];
                const float r = rsqrtf(wave_sum(ss) * (1.0f / 512.0f) + EPS);
                const int c0 = 8 * lane; const f32x4 g0 = kgv[0], g1 = kgv[1];
                u32x4 o; o.x = pkbf(v[0] * r * g0[0], v[1] * r * g0[1]); o.y = pkbf(v[2] * r * g0[2], v[3] * r * g0[3]);
                o.z = pkbf(v[4] * r * g1[0], v[5] * r * g1[1]); o.w = pkbf(v[6] * r * g1[2], v[7] * r * g1[3]);
                *(u32x4*)((bf16_t*)(a->ws + WS_KVIN) + (size_t)row * 512 + c0) = o;
            }
            {
                float o = val;
                if (row < NX) o = half ? (val * cs + par * sn) : (val * cs - par * sn);
                ((bf16_t*)(a->ws + WS_KR))[(size_t)row * 64 + lane] = (bf16_t)f2bf(o);
            }
        }
    }
}
typedef float f32x16 __attribute__((ext_vector_type(16)));
#define MFMA32(a, b, c) __builtin_amdgcn_mfma_f32_32x32x16_bf16((a), (b), (c), 0, 0, 0)
constexpr int AT_KP = 400, AT_VP = 144, AT_KB = 64 * AT_KP, AT_VB = 128 * AT_VP, AT_STAGE = AT_KB + AT_VB;
static_assert(2 * AT_STAGE <= RING_BYTES, "attention LDS");
template <bool ISX>
__device__ __forceinline__ void attn_unit(ArgP a, LAS unsigned char* lds, int b, int h, int qb, int tid, int lane, int wave) {
    unsigned char* ws = a->ws;
    const bf16_t* Q = (const bf16_t*)(ws + WS_Q); const bf16_t* KN = (const bf16_t*)(ws + WS_KN); const bf16_t* KR = (const bf16_t*)(ws + WS_KR); const bf16_t* VT = (const bf16_t*)(ws + WS_VT);
    const int r = lane & 31, hh = lane >> 5;
    const int qrow = (ISX ? b * SEQ + qb * 256 : NX + b * CTXL) + wave * 32 + r;
    constexpr int NKT = ISX ? 36 : 4;
    bf16x8 qf[12];
    { const bf16_t* qp = Q + (size_t)qrow * 3072 + h * 192 + 8 * hh;
#pragma unroll
      for (int ks = 0; ks < 12; ++ks) qf[ks] = *(const bf16x8*)(qp + 16 * ks); }
    const int skey = tid >> 3, sch = tid & 7;
    u32x4 kst[3], vst[2];
#define AT_KROW0(kt) (ISX ? ((kt) < 32 ? b * SEQ + (kt) * 64 : NX + b * CTXL + ((kt) - 32) * 64) : (NX + b * CTXL + (kt) * 64))
    const unsigned vo_kn = (unsigned)(skey * 4096 + sch * 16), vo_kr = (unsigned)(skey * 128 + sch * 16), vo_vt = (unsigned)(skey * (NR * 2) + sch * 16);
    const char* const knb = (const char*)(KN + h * 128); const char* const krb = (const char*)KR; const char* const vtb = (const char*)(VT + (size_t)(h * 128) * NR);
#define AT_LOAD(kt) do { const int kr0_ = AT_KROW0(kt); \
        const char* kp_ = knb + (size_t)kr0_ * 4096; const char* rp_ = krb + (size_t)kr0_ * 128; const char* vp0_ = vtb + (size_t)kr0_ * 2; \
        kst[0] = *(const u32x4*)(kp_ + vo_kn); kst[1] = *(const u32x4*)(kp_ + 128 + vo_kn); kst[2] = *(const u32x4*)(rp_ + vo_kr); \
        vst[0] = *(const u32x4*)(vp0_ + vo_vt); vst[1] = *(const u32x4*)(vp0_ + (size_t)64 * NR * 2 + vo_vt); } while (0)
#define AT_WRITE(boff) do { LAS unsigned char* sb_ = lds + (boff); \
        _Pragma("unroll") for (int i = 0; i < 3; ++i) *(LAS u32x4*)(sb_ + skey * AT_KP + (sch + 8 * i) * 16) = kst[i]; \
        _Pragma("unroll") for (int i = 0; i < 2; ++i) { LAS unsigned char* vp_ = sb_ + AT_KB + (skey + 64 * i) * AT_VP + (sch >> 1) * 32 + (sch & 1) * 8; \
            *(LAS u32x2*)vp_ = (u32x2){vst[i].x, vst[i].y}; *(LAS u32x2*)(vp_ + 16) = (u32x2){vst[i].z, vst[i].w}; } } while (0)
    f32x16 o[4];
#pragma unroll
    for (int dt = 0; dt < 4; ++dt)
#pragma unroll
        for (int i = 0; i < 16; ++i) o[dt][i] = 0.f;
    float m = 0.f, l = 0.f;
    f32x16 s0, s1;
#define AT_S(boff) do { const LAS unsigned char* kb = lds + (boff); \
        { const float ni_ = -m; _Pragma("unroll") for (int i = 0; i < 16; ++i) { s0[i] = ni_; s1[i] = ni_; } }     \
        _Pragma("unroll") for (int ks = 0; ks < 12; ++ks) { \
            const bf16x8 a0 = *(const LAS bf16x8*)(kb + r * AT_KP + ks * 32 + hh * 16); \
            const bf16x8 a1 = *(const LAS bf16x8*)(kb + (32 + r) * AT_KP + ks * 32 + hh * 16); \
            s0 = MFMA32(a0, qf[ks], s0); s1 = MFMA32(a1, qf[ks], s1); \
            if ((ks & 3) == 3) __builtin_amdgcn_sched_barrier(0); } } while (0)
#define AT_MAX32(dst) do { float x0_ = s0[0], x1_ = s1[0];     \
        _Pragma("unroll") for (int i = 1; i < 16; ++i) { x0_ = fmaxf(x0_, s0[i]); x1_ = fmaxf(x1_, s1[i]); } \
        dst = fmaxf(x0_, x1_); dst = fmaxf(dst, __shfl_xor(dst, 32)); } while (0)
#define AT_SOFTMAX_PV(boff, FIRST) do { const LAS unsigned char* vb = lds + (boff) + AT_KB; const bool first_ = (FIRST); \
        { float mx_; AT_MAX32(mx_); \
            if (__any(mx_ > (first_ ? -3.0e38f : 6.0f))) { \
                const float up = first_ ? mx_ : fmaxf(mx_, 0.f); const float alpha = first_ ? 1.0f : __builtin_amdgcn_exp2f(-up); m += up; l *= alpha; \
                _Pragma("unroll") for (int i = 0; i < 16; ++i) { s0[i] -= up; s1[i] -= up; } \
                _Pragma("unroll") for (int dt = 0; dt < 4; ++dt) _Pragma("unroll") for (int i = 0; i < 16; ++i) o[dt][i] *= alpha; } } \
        float ls = 0.f; \
        _Pragma("unroll") for (int i = 0; i < 16; ++i) { s0[i] = __builtin_amdgcn_exp2f(s0[i]); s1[i] = __builtin_amdgcn_exp2f(s1[i]); ls += s0[i] + s1[i]; } \
        l += ls; \
        _Pragma("unroll") for (int gq = 0; gq < 4; ++gq) { \
            const int t = gq >> 1, sj = gq & 1; u32x4 pw; \
            if (t == 0) { pw.x = pkbf(s0[8 * sj + 0], s0[8 * sj + 1]); pw.y = pkbf(s0[8 * sj + 2], s0[8 * sj + 3]); pw.z = pkbf(s0[8 * sj + 4], s0[8 * sj + 5]); pw.w = pkbf(s0[8 * sj + 6], s0[8 * sj + 7]); } \
            else        { pw.x = pkbf(s1[8 * sj + 0], s1[8 * sj + 1]); pw.y = pkbf(s1[8 * sj + 2], s1[8 * sj + 3]); pw.z = pkbf(s1[8 * sj + 4], s1[8 * sj + 5]); pw.w = pkbf(s1[8 * sj + 6], s1[8 * sj + 7]); } \
            const bf16x8 pb = __builtin_bit_cast(bf16x8, pw); \
            _Pragma("unroll") for (int dt = 0; dt < 4; ++dt) { \
                const bf16x8 vfr = *(const LAS bf16x8*)(vb + (dt * 32 + r) * AT_VP + (2 * t + sj) * 32 + hh * 16); \
                o[dt] = MFMA32(vfr, pb, o[dt]); } \
            __builtin_amdgcn_sched_barrier(0); } } while (0)
    AT_LOAD(0); AT_WRITE(0);
    __syncthreads();
    for (int j = 0; j < NKT; ++j) {
        if (j + 1 < NKT) AT_LOAD(j + 1);
        const int bcur = (j & 1) * AT_STAGE;
        AT_S(bcur);
        AT_SOFTMAX_PV(bcur, j == 0);
        if (j + 1 < NKT) AT_WRITE(((j + 1) & 1) * AT_STAGE);
        __syncthreads();
    }
    l += __shfl_xor(l, 32);
    const float inv = 1.0f / l;
    bf16_t* op = (bf16_t*)(ws + WS_O) + (size_t)qrow * 2048 + h * 128 + 4 * hh;
#pragma unroll
    for (int dt = 0; dt < 4; ++dt)
#pragma unroll
        for (int g4 = 0; g4 < 4; ++g4) {
            u32x2 w; w.x = pkbf(o[dt][4 * g4] * inv, o[dt][4 * g4 + 1] * inv); w.y = pkbf(o[dt][4 * g4 + 2] * inv, o[dt][4 * g4 + 3] * inv);
            *(u32x2*)(op + dt * 32 + 8 * g4) = w; }
#undef AT_KROW0
#undef AT_LOAD
#undef AT_WRITE
#undef AT_S
#undef AT_MAX32
#undef AT_SOFTMAX_PV
}
__device__ __forceinline__ void phase_attn(ArgP a, int l, LAS unsigned char* lds, int tid, int lane, int wave) {
    const int G = gridDim.x;
    if (G == 256) {
        const int xcd = blockIdx.x & 7, slot = blockIdx.x >> 3;
        for (int i = 0; i < 2; ++i) { const int pair = xcd * 8 + i * 4 + (slot >> 3), qb = slot & 7; attn_unit<true>(a, lds, pair >> 4, pair & 15, qb, tid, lane, wave); }
    } else
    for (int u = blockIdx.x; u < NB * 16 * 8; u += G) { const int qb = u & 7, h = (u >> 3) & 15, b = u >> 7; attn_unit<true>(a, lds, b, h, qb, tid, lane, wave); }
    if (l != DEPTH - 1) for (int u = (int)((blockIdx.x + G / 2) % G); u < NB * 16; u += G) { const int h = u & 15, b = u >> 4; attn_unit<false>(a, lds, b, h, 0, tid, lane, wave); }
}

constexpr int NPRO = 3, NPL = 11, NPHASE = NPRO + DEPTH * NPL;

__global__ void __launch_bounds__(512, 2) fwd_kernel(Args a_unused) {
    extern __shared__ __attribute__((aligned(16))) unsigned char lds_raw[];
    LAS unsigned char* lds = (LAS unsigned char*)lds_raw;
    const int tid = threadIdx.x, lane = tid & 63, wave = __builtin_amdgcn_readfirstlane(tid >> 6);
    const int lo = get_args()->ph_lo, hi = get_args()->ph_hi;
    volatile LAS unsigned* MISC = (volatile LAS unsigned*)(lds + MISC_OFF);
    if (tid < 16) MISC[tid] = 0u;
    __syncthreads();
    XcdBarrier bar; bar.bar = (unsigned*)(get_args()->ws + WS_CTL) + CW_BAR; bar.x = 0; bar.st = MISC + 8;
    if (hi - lo > 1) bar = xcd_barrier_post((unsigned*)(get_args()->ws + WS_CTL) + CW_BAR, MISC + 8);
#ifndef ONLYP
#define ONLYP (-1)
#endif
#ifndef ONLYS
#define ONLYS (-1)
#endif
#define SUB(k) (ONLYS < 0 || ONLYS == (k))
#define EN(k) (ONLYP < 0 || ONLYP == (k))
#define INR(p) (lo <= (p) && (p) < hi)
#define RUN(p) (EN(p) && INR(p))
#define RUNL(j) (EN(NPRO + (j)) && INR(pb + (j)))
#define SEAM(p) do { if (INR(p) && INR((p) + 1)) xcd_barrier(bar); } while (0)
#ifndef DUPK
#define DUPK (-1)
#endif
#ifndef DUPS
#define DUPS (-1)
#endif
#define REP(k) for (int rep_ = 0; rep_ < ((DUPK == (k) && DUPS < 0) ? 2 : 1); ++rep_)
#define REPS(k, sidx) for (int reps_ = 0; reps_ < ((DUPK == (k) && DUPS == (sidx)) ? 2 : 1); ++reps_)
    const int G = gridDim.x, cid = blockIdx.x;
    if (RUN(0)) REP(0) { if (rep_) xcd_barrier(bar); const int t_ = fresh_tid(); phase_pro0(get_args(), lds, t_, t_ & 63, __builtin_amdgcn_readfirstlane(t_ >> 6)); }
    SEAM(0);
    if (RUN(1)) { const int t_ = fresh_tid(); phase_pro1(get_args(), lds, t_); }
    SEAM(1);
    if (RUN(2)) { const int t_ = fresh_tid(); phase_pro2(get_args(), t_ & 63, __builtin_amdgcn_readfirstlane(t_ >> 6)); }
    SEAM(2);
    for (int l = 0; l < DEPTH; ++l) {
        const int pb = NPRO + l * NPL;
        const bool lastl = (l == DEPTH - 1);
        const int nMq = lastl ? 32 : 36;
        int rot = 0;
        if (RUNL(0)) REP(3) {
            rot = 0;
            if (rep_) xcd_barrier(bar);
            unsigned char* ws = get_args()->ws; unsigned char* wl = ws + WS_W + (size_t)l * LW; (void)wl;
            {
                pg8::Gemm g{(const bf16_t*)(ws + WS_H), (const bf16_t*)(wl + OW_IN) + (size_t)1024 * 4096, 4096, 4096, 4096, 0, 0};
                pg8::Order S; S.init(36, (NU - 1024) / 256, 1, G, (cid + G - rot) % G); rot = (rot + (36) * ((NU - 1024) / 256) * (1)) % G;
                pg8::EpiBf16<0> E{(bf16_t*)(ws + WS_U) + 1024, NU, nullptr, 0};
                pg8::gemm_phase(lds, g, S, E);
            }
            {
                pg8::Gemm g{(const bf16_t*)(wl + OW_IN), (const bf16_t*)(ws + WS_H), 4096, 4096, 4096, 0, 0};
                pg8::Order S; S.init(4, 36, 1, G, (cid + G - rot) % G); rot = (rot + (4) * (36) * (1)) % G;
                pg8::EpiUfT E{(bf16_t*)(ws + WS_UFTX), (bf16_t*)(ws + WS_UFTT)};
                pg8::gemm_phase(lds, g, S, E);
            }
        }
        SEAM(pb + 0);
        if (RUNL(1)) REP(4) { if (rep_) xcd_barrier(bar); const int t_ = fresh_tid(); phase_postu(get_args(), l, lds, t_, t_ & 63, __builtin_amdgcn_readfirstlane(t_ >> 6)); }
        SEAM(pb + 1);
        if (RUNL(2)) REP(5) {
            rot = 0;
            if (rep_) xcd_barrier(bar);
            unsigned char* ws = get_args()->ws; unsigned char* wl = ws + WS_W + (size_t)l * LW; (void)wl;
#pragma unroll 1
            for (int k_ = 0; k_ < (lastl ? 1 : 2); ++k_) {
                int kk = k_; asm volatile("" : "+s"(kk));
                if (!SUB(kk)) continue;
                pg8::Gemm g{(const bf16_t*)(ws + (kk ? WS_DFTT : WS_DFTX)), (const bf16_t*)(ws + (kk ? WS_UFTT : WS_UFTX)), kk ? 256 : 2048, kk ? 256 : 2048, kk ? 256 : 2048, 0, kk ? (size_t)1024 * 256 : (size_t)1024 * 2048};
                pg8::Order S; S.init(kk ? 2 : 8, 4, 4, G, cid);
                pg8::EpiSeqDft E{(bf16_t*)(ws + WS_G), kk ? 1 : 4, kk ? 256 : 2048, kk ? NX : 0, kk ? 0u : 1023u, kk ? 0 : 1};
                pg8::gemm_phase(lds, g, S, E);
            }
            if (SUB(2)) {
                pg8::Gemm g{(const bf16_t*)(ws + WS_QIN), (const bf16_t*)(wl + OW_UQ), 1024, 1024, 1024, 0, 0};
                pg8::Order S; S.init(nMq, 12, 1, G, (cid + G - (lastl ? 128 : 64)) % G); rot = (rot + (nMq) * (12) * (1)) % G;
                if (G == 256) {
                    if (cid < 128) { S.c = cid; S.Lend = 128; }
                    else { S.c = 128 + ((cid - 128 + 128 - 80) & 127); S.G = 128; }
                }
                pg8::EpiQRope E{(bf16_t*)(ws + WS_Q), (const float*)(ws + WS_ROPE)};
                pg8::gemm_phase(lds, g, S, E);
            }
#pragma unroll 1
            for (int k_ = 0; k_ < 2; ++k_) {
                int kk = k_; asm volatile("" : "+s"(kk));
                if (!SUB(3)) continue;
                const bf16_t* kvin = (const bf16_t*)(ws + WS_KVIN); const bf16_t* wkv = (const bf16_t*)(wl + OW_UKV);
                pg8::Gemm g{kk ? wkv + (size_t)2048 * 512 : kvin, kk ? kvin : wkv, 512, 512, 512, 0, 0};
                pg8::Order S; S.init(kk ? 8 : 36, kk ? 36 : 8, 1, G, (cid + G - (kk ? 128 : (lastl ? 160 : 176))) % G);
                pg8::EpiBf16<0> E{(bf16_t*)(ws + (kk ? WS_VT : WS_KN)), kk ? NR : 2048, nullptr, 0};
                pg8::gemm_phase(lds, g, S, E);
            }
            if (SUB(4)) {
                pg8::Gemm g{(const bf16_t*)(ws + WS_U) + U_GA, (const bf16_t*)(wl + OW_GB), NU, 512, 512, 0, 0};
                pg8::Order S; S.init(nMq, 48, 1, G, (cid + G - (lastl ? 128 : 128)) % G); rot = (rot + (nMq) * (48) * (1)) % G;
                if (G == 256) S.Lend -= G - nMq * 4;
                pg8::EpiGatesImg E{(bf16_t*)(ws + WS_GATES), get_args()->in[I_BGATE] + (size_t)l * 12288};
                pg8::gemm_phase(lds, g, S, E);
            }
        }
        SEAM(pb + 2);
        if (RUNL(3)) {
            rot = 0;
            unsigned char* ws = get_args()->ws; unsigned char* wl = ws + WS_W + (size_t)l * LW; (void)wl;
            if (SUB(0)) {
                pg8::Gemm g{(const bf16_t*)(ws + WS_G), (const bf16_t*)(ws + WS_DFTC), 2048, 512, 512, 512, 0};
                pg8::Order S; S.init(nMq, 1, 4, G, (cid + G - rot) % G); rot = (rot + (nMq) * (1) * (4)) % G;
                pg8::EpiBf16<0> E{(bf16_t*)(ws + WS_F), 1024, nullptr, 256};
                pg8::gemm_phase(lds, g, S, E);
            }
            if (SUB(0) && G == 256) {
                pg8::Gemm g{(const bf16_t*)(ws + WS_U) + U_GA, (const bf16_t*)(wl + OW_GB), NU, 512, 512, 0, 0};
                pg8::Order S; S.init(nMq, 48, 1, G, 0); const int nch = nMq * 4; S.c = cid >= nch ? S.Lend - (G - nch) + (cid - nch) : S.Lend;
                pg8::EpiGatesImg E{(bf16_t*)(ws + WS_GATES), get_args()->in[I_BGATE] + (size_t)l * 12288};
                pg8::gemm_phase(lds, g, S, E);
            }
        }
        SEAM(pb + 3);
        if (RUNL(4)) {
            rot = 0;
            unsigned char* ws = get_args()->ws; unsigned char* wl = ws + WS_W + (size_t)l * LW; (void)wl;
#pragma unroll 1
            for (int part = 0; part < 3; ++part) {
                int part_ = part; asm volatile("" : "+s"(part_));
                if ((part_ == 0 && (cid & 1)) || (part_ == 2 && !(cid & 1))) { const int t_ = fresh_tid(); phase_attn(get_args(), l, lds, t_, t_ & 63, __builtin_amdgcn_readfirstlane(t_ >> 6)); }
                if (part_ == 1) {
                    pg8::Gemm g{(const bf16_t*)(ws + WS_CACT), (const bf16_t*)(wl + OW_PC), 1024, 1024, 1024, (size_t)0, (size_t)0};
                    g.aZ = (size_t)0 - (size_t)((WS_CACT - WS_F) / 2); g.bZ = (size_t)0 - (size_t)((OW_PC - OW_PF) / 2);
                    pg8::Order S; S.init(nMq, 16, 2, G, (cid + G - rot) % G); rot = (rot + (nMq) * (16) * (2)) % G;
                    pg8::EpiGate<0> E{(bf16_t*)(ws + WS_M1), (const bf16_t*)(ws + WS_GATES), nullptr};
                    pg8::gemm_phase(lds, g, S, E);
                }
            }
        }
        SEAM(pb + 4);
        if (RUNL(5)) REP(8) {
            rot = 0;
            if (rep_) xcd_barrier(bar);
            unsigned char* ws = get_args()->ws; unsigned char* wl = ws + WS_W + (size_t)l * LW; (void)wl;
            pg8::Gemm g{(const bf16_t*)(ws + WS_O), (const bf16_t*)(wl + OW_PM), 2048, 2048, 2048, 0, 0};
            pg8::Order S; S.init(nMq, 16, 1, G, (cid + G - rot) % G); rot = (rot + (nMq) * (16) * (1)) % G;
            pg8::EpiGate<2> E{(bf16_t*)(ws + WS_M1), (const bf16_t*)(ws + WS_GATES), (bf16_t*)(ws + WS_MERGED)};
            pg8::gemm_phase(lds, g, S, E);
            if (!lastl && G == 256 && cid >= 64 && rep_ == 0) {
                const int t_ = fresh_tid(); const int ln_ = t_ & 63, wv_ = __builtin_amdgcn_readfirstlane(t_ >> 6);
                const float* W1 = get_args()->in[I_WFF1] + (size_t)(l + 1) * 4096 * DFF; bf16_t* W1T = (bf16_t*)(ws + WS_W + (size_t)(l + 1) * LW + OW_1);
                const float* W2 = get_args()->in[I_WFF2] + (size_t)(l + 1) * DFF * 4096; bf16_t* W2T = (bf16_t*)(ws + WS_W + (size_t)(l + 1) * LW + OW_2);
                LAS float* scr = (LAS float*)(lds + wv_ * 16384); const int w0_ = (cid - 64) * 8 + wv_;
#pragma unroll 1
                for (int i = 0; i < DEF_PER_WAVE; ++i) { const int c_ = w0_ + DEF_WAVES * i;
                    if (c_ < W1_ITEMS) transpose_item<false>(W1, DFF, W1T, 4096, 0, scr, c_, ln_); else transpose_item<false>(W2, 4096, W2T, DFF, 0, scr, c_ - W1_ITEMS, ln_); }
            }
        }
        SEAM(pb + 5);
#pragma unroll 1
        for (int hf_ = 0; hf_ < 2; ++hf_) {
            int hf = hf_; asm volatile("" : "+s"(hf));
            if (hf) {
                if (RUNL(8)) {
                    unsigned char* ws = get_args()->ws; unsigned char* wl = ws + WS_W + (size_t)l * LW; (void)wl;
                    pg8::Gemm g{(const bf16_t*)(ws + WS_H), (const bf16_t*)(wl + OW_1), 4096, 4096, 4096, 0, 0};
                    pg8::Order S; S.init(nMq, 64, 1, G, cid);
                    pg8::EpiBf16<2> E{(bf16_t*)(ws + WS_HID), DFF, nullptr, 0};
                    pg8::gemm_phase(lds, g, S, E);
                }
                SEAM(pb + 8);
            }
            if (RUNL(6 + 3 * hf)) {
                rot = 0;
                unsigned char* ws = get_args()->ws; unsigned char* wl = ws + WS_W + (size_t)l * LW; (void)wl;
                const int Kd = hf ? DFF : 4096;
                const bf16_t* Ap = (const bf16_t*)(ws + (hf ? WS_HID : WS_MERGED)); const bf16_t* Bp = (const bf16_t*)(wl + (hf ? OW_2 : OW_OUT));
                {
                    pg8::Gemm g{Ap, Bp, Kd, Kd, Kd, 0, 0};
                    pg8::Order S; S.init(32, 16, 1, G, (cid + G - rot) % G); rot = (rot + (32) * (16) * (1)) % G;
                    S.rev = hf;
                    pg8::EpiBf16<0> E{(bf16_t*)(ws + WS_Y), 4096, nullptr, 0};
                    pg8::gemm_phase(lds, g, S, E);
                }
                if (!lastl) {
                    pg8::Gemm g{Ap + (size_t)NX * Kd, Bp, Kd, Kd, Kd / 4, (size_t)(Kd / 4), (size_t)(Kd / 4)};
                    pg8::Order S; S.init(4, 16, 4, G, (cid + G - rot) % G); rot = (rot + (4) * (16) * (4)) % G;
                    pg8::EpiF32 E{(float*)(ws + WS_YS), 4096, (size_t)NT * 4096};
                    pg8::gemm_phase(lds, g, S, E);
                }
            }
            SEAM(pb + 6 + 3 * hf);
            if (RUNL(7 + 3 * hf)) { const int t_ = fresh_tid(); phase_residual(get_args(), l, hf, lds, t_, t_ & 63, __builtin_amdgcn_readfirstlane(t_ >> 6)); }
            SEAM(pb + 7 + 3 * hf);
        }
    }
#undef RUN
#undef RUNL
#undef SEAM
}

extern "C" void kernel_launch(void* const* d_in, const int* in_sizes, int n_in, void* d_out, int out_size, void* d_ws, size_t ws_size, hipStream_t stream) {
    static int grid = 0;
    if (grid == 0) {
        if (n_in != 29 || out_size != NX * DM || ws_size < WS_END) { fprintf(stderr, "kernel_launch: unexpected shapes (n_in %d out %d ws %zu need %zu)\n", n_in, out_size, ws_size, (size_t)WS_END); grid = -1; return; }
        int dev = 0, cus = 0, per_cu = 0;
        if (hipGetDevice(&dev) != hipSuccess || hipDeviceGetAttribute(&cus, hipDeviceAttributeMultiprocessorCount, dev) != hipSuccess) { grid = -1; return; }
        if (hipFuncSetAttribute((const void*)fwd_kernel, hipFuncAttributeMaxDynamicSharedMemorySize, LDS_BYTES) != hipSuccess) { fprintf(stderr, "kernel_launch: hipFuncSetAttribute failed\n"); grid = -1; return; }
        if (hipOccupancyMaxActiveBlocksPerMultiprocessor(&per_cu, (const void*)fwd_kernel, 512, LDS_BYTES) != hipSuccess || per_cu < 1) { fprintf(stderr, "kernel_launch: occupancy query says %d\n", per_cu); }
        (void)hipGetLastError();
        if (cus < 256) { fprintf(stderr, "kernel_launch: built for a 256-CU device (got %d CUs)\n", cus); grid = -1; return; }
        grid = 256;
    }
    if (grid < 0) return;
    (void)hipMemsetAsync((char*)d_ws + WS_CTL, 0, CTL_BYTES, stream);
    Args a{};
    for (int i = 0; i < 29; ++i) a.in[i] = (const float*)d_in[i];
    a.out = (float*)d_out; a.ws = (unsigned char*)d_ws;
#if ONE_LAUNCH
    a.ph_lo = 0; a.ph_hi = NPHASE;
    hipLaunchKernelGGL(fwd_kernel, dim3(grid), dim3(512), LDS_BYTES, stream, a);
#else
    for (int p = 0; p < NPHASE; ++p) { a.ph_lo = p; a.ph_hi = p + 1; hipLaunchKernelGGL(fwd_kernel, dim3(grid), dim3(512), LDS_BYTES, stream, a); }
#endif
}
```
